# Optimizing an MI355X kernel written in HIP

```python
import jax, jax.numpy as jnp
from jax import lax
import numpy as np

D_MODEL = 1024
BATCH = 1
SEQ = 16384
DEPTH = 1

MEM_LEN = 256
HEAD_DIM = 64
EPS = 1e-6
N_LRU_HEADS = 6
D_LRU = N_LRU_HEADS * HEAD_DIM
CONV_WIDTH = 4
LRU_C = 8.0
N_SWA_HEADS = 6
N_SWA_KV = 2
SWA_GROUP = N_SWA_HEADS // N_SWA_KV
D_SWA = N_SWA_HEADS * HEAD_DIM
D_SWA_KV = N_SWA_KV * HEAD_DIM
WINDOW = 128
BLOCK = 128
N_MEM_HEADS = 4
D_MEM = N_MEM_HEADS * HEAD_DIM
D_MIX = D_LRU + D_SWA + D_MEM
D_IN = 2 * D_LRU + D_SWA + 2 * D_SWA_KV + D_MEM
N_EXPERTS = 32
TOP_K = 4
D_FF = D_MODEL
SWIGLU_ALPHA = 1.702
SWIGLU_LIMIT = 7.0
MOE_BLOCK = 128

kernel_name = "hymba_style_rglru_swa_sink_mem_moe"


def rms_norm(x, g):
    xf = x.astype(jnp.float32)
    y = xf * lax.rsqrt(jnp.mean(xf * xf, axis=-1, keepdims=True) + EPS)
    return (y * g.astype(jnp.float32)).astype(x.dtype)


def causal_depthwise_conv(x, w, b):
    S = x.shape[1]
    xp = jnp.pad(x, ((0, 0), (CONV_WIDTH - 1, 0), (0, 0)))
    out = b + xp[:, 0:S] * w[0]
    for k in range(1, CONV_WIDTH):
        out = out + xp[:, k:k + S] * w[k]
    return out


def rg_lru(xb, w_a, b_a, w_x, b_x, lam):
    B, S, _ = xb.shape
    xf = xb.astype(jnp.float32)
    xh = xf.reshape(B, S, N_LRU_HEADS, HEAD_DIM)
    r = jax.nn.sigmoid(jnp.einsum('bshi,hij->bshj', xh, w_a.astype(jnp.float32)).reshape(B, S, D_LRU) + b_a)
    i = jax.nn.sigmoid(jnp.einsum('bshi,hij->bshj', xh, w_x.astype(jnp.float32)).reshape(B, S, D_LRU) + b_x)
    log_a = -LRU_C * r * jax.nn.softplus(-lam.astype(jnp.float32))
    a = jnp.exp(log_a)
    bx = jnp.sqrt(-jnp.expm1(2.0 * log_a)) * (i * xf)

    def combine(left, right):
        a_l, b_l = left
        a_r, b_r = right
        return a_l * a_r, a_r * b_l + b_r

    _, h = lax.associative_scan(combine, (a, bx), axis=1)
    return h.astype(xb.dtype)


def sliding_window_sink_attention(q, k, v, sinks):
    B, S, _, _ = q.shape
    NB = S // BLOCK
    scale = HEAD_DIM ** -0.5
    qb = q.reshape(B, NB, BLOCK, N_SWA_KV, SWA_GROUP, HEAD_DIM)
    kb = k.reshape(B, NB, BLOCK, N_SWA_KV, HEAD_DIM)
    vb = v.reshape(B, NB, BLOCK, N_SWA_KV, HEAD_DIM)
    pad = ((0, 0), (1, 0), (0, 0), (0, 0), (0, 0))
    kk = jnp.concatenate([jnp.pad(kb, pad)[:, :-1], kb], axis=2)
    vv = jnp.concatenate([jnp.pad(vb, pad)[:, :-1], vb], axis=2)
    s = jnp.einsum('bnqhgd,bnkhd->bnhgqk', qb, kk).astype(jnp.float32) * scale
    qi = jnp.arange(BLOCK)[:, None]
    kj = jnp.arange(2 * BLOCK)[None, :]
    rel = qi + BLOCK - kj
    band = (rel >= 0) & (rel < WINDOW)
    has_prev = (jnp.arange(NB)[:, None] > 0) | (kj >= BLOCK)
    mask = band[None] & has_prev[:, None, :]
    s = jnp.where(mask[None, :, None, None], s, -jnp.inf)
    sink = jnp.broadcast_to(sinks.astype(jnp.float32).reshape(N_SWA_KV, SWA_GROUP)[None, None, :, :, None, None],
                            s.shape[:-1] + (1,))
    p = jax.nn.softmax(jnp.concatenate([s, sink], axis=-1), axis=-1)[..., :-1]
    o = jnp.einsum('bnhgqk,bnkhd->bnqhgd', p.astype(v.dtype), vv)
    return o.reshape(B, S, D_SWA)


def memory_cross_attention(q, km, vm):
    B, S, _, _ = q.shape
    s = jnp.einsum('bshd,bmhd->bhsm', q, km).astype(jnp.float32) * (HEAD_DIM ** -0.5)
    p = jax.nn.softmax(s, axis=-1)
    o = jnp.einsum('bhsm,bmhd->bshd', p.astype(vm.dtype), vm)
    return o.reshape(B, S, D_MEM)


def clamped_swiglu(h):
    x_glu = jnp.minimum(h[..., ::2], SWIGLU_LIMIT)
    x_lin = jnp.clip(h[..., 1::2], -SWIGLU_LIMIT, SWIGLU_LIMIT)
    return x_glu * jax.nn.sigmoid(SWIGLU_ALPHA * x_glu) * (x_lin + 1.0)


def moe(xn, w_router, b_router, w1, b1, w2, b2):
    Bn, S, D = xn.shape
    N = Bn * S
    xt = xn.reshape(N, D)
    logits = (xt @ w_router).astype(jnp.float32) + b_router.astype(jnp.float32)
    top_vals, top_idx = lax.top_k(logits, TOP_K)
    gates = jax.nn.softmax(top_vals, axis=-1)
    A = N * TOP_K
    e_flat = top_idx.reshape(A).astype(jnp.int32)
    g_flat = gates.reshape(A)
    tok_flat = jnp.repeat(jnp.arange(N, dtype=jnp.int32), TOP_K)
    order = jnp.argsort(e_flat)
    e_sorted = e_flat[order]
    counts = jnp.bincount(e_flat, length=N_EXPERTS)
    starts = jnp.cumsum(counts) - counts
    padded = ((counts + MOE_BLOCK - 1) // MOE_BLOCK) * MOE_BLOCK
    pad_ends = jnp.cumsum(padded)
    pad_starts = pad_ends - padded
    dest = pad_starts[e_sorted] + jnp.arange(A, dtype=jnp.int32) - starts[e_sorted]
    n_blocks = -(-A // MOE_BLOCK) + N_EXPERTS
    P = n_blocks * MOE_BLOCK
    tok_buf = jnp.zeros((P,), jnp.int32).at[dest].set(tok_flat[order])
    gate_buf = jnp.zeros((P,), jnp.float32).at[dest].set(g_flat[order])
    block_expert = jnp.minimum(
        jnp.searchsorted(pad_ends, jnp.arange(n_blocks) * MOE_BLOCK, side='right'), N_EXPERTS - 1)
    xb = xt[tok_buf].reshape(n_blocks, MOE_BLOCK, D)

    def expert_block(args):
        xblk, e = args
        h = xblk @ w1[e] + b1[e]
        return clamped_swiglu(h) @ w2[e] + b2[e]

    yb = lax.map(expert_block, (xb, block_expert)).reshape(P, D)
    out = jnp.zeros((N, D), jnp.float32).at[tok_buf].add(yb.astype(jnp.float32) * gate_buf[:, None])
    return out.astype(xn.dtype).reshape(Bn, S, D)


def setup_inputs(seed: int = 0) -> dict:
    key = jax.random.key(seed)
    ks = jax.random.split(key, 32)
    f32 = jnp.float32
    L = DEPTH

    def nrm(k, shape, scale):
        return jax.random.normal(k, shape, f32) * scale

    def gain(k, shape):
        return 1.0 + 0.05 * jax.random.normal(k, shape, f32)

    u = jax.random.uniform(ks[8], (L, D_LRU), f32, 0.9, 0.999)
    a0 = u ** (1.0 / LRU_C)
    lam = jnp.log(a0) - jnp.log1p(-a0)
    return {
        "x": jax.random.normal(ks[0], (BATCH, SEQ, D_MODEL), f32),
        "mem": jax.random.normal(ks[1], (BATCH, MEM_LEN, D_MODEL), f32),
        "g_mix": gain(ks[2], (L, D_MODEL)),
        "w_in": nrm(ks[3], (L, D_MODEL, D_IN), D_MODEL ** -0.5),
        "conv_w": nrm(ks[4], (L, CONV_WIDTH, D_LRU), CONV_WIDTH ** -0.5),
        "conv_b": nrm(ks[5], (L, D_LRU), 0.02),
        "lru_wa": nrm(ks[6], (L, N_LRU_HEADS, HEAD_DIM, HEAD_DIM), HEAD_DIM ** -0.5),
        "lru_ba": nrm(ks[7], (L, D_LRU), 0.02),
        "lru_wx": nrm(ks[9], (L, N_LRU_HEADS, HEAD_DIM, HEAD_DIM), HEAD_DIM ** -0.5),
        "lru_bx": nrm(ks[10], (L, D_LRU), 0.02),
        "lru_lambda": lam,
        "q_norm_swa": gain(ks[11], (L, HEAD_DIM)),
        "k_norm_swa": gain(ks[12], (L, HEAD_DIM)),
        "swa_sinks": nrm(ks[13], (L, N_SWA_HEADS), 0.5),
        "g_mem": gain(ks[14], (L, D_MODEL)),
        "w_mem_kv": nrm(ks[15], (L, D_MODEL, 2 * D_MEM), D_MODEL ** -0.5),
        "q_norm_mem": gain(ks[16], (L, HEAD_DIM)),
        "k_norm_mem": gain(ks[17], (L, HEAD_DIM)),
        "g_out_lru": gain(ks[18], (L, D_LRU)),
        "g_out_swa": gain(ks[19], (L, D_SWA)),
        "g_out_mem": gain(ks[20], (L, D_MEM)),
        "w_out": nrm(ks[21], (L, D_MIX, D_MODEL), D_MIX ** -0.5),
        "g_ffn": gain(ks[22], (L, D_MODEL)),
        "w_router": nrm(ks[23], (L, D_MODEL, N_EXPERTS), D_MODEL ** -0.5),
        "b_router": nrm(ks[24], (L, N_EXPERTS), 0.01),
        "w1": nrm(ks[25], (L, N_EXPERTS, D_MODEL, 2 * D_FF), D_MODEL ** -0.5),
        "b1": nrm(ks[26], (L, N_EXPERTS, 2 * D_FF), 0.02),
        "w2": nrm(ks[27], (L, N_EXPERTS, D_FF, D_MODEL), D_FF ** -0.5),
        "b2": nrm(ks[28], (L, N_EXPERTS, D_MODEL), 0.02),
    }


def reference(x, mem, g_mix, w_in, conv_w, conv_b, lru_wa, lru_ba, lru_wx, lru_bx, lru_lambda,
              q_norm_swa, k_norm_swa, swa_sinks, g_mem, w_mem_kv, q_norm_mem, k_norm_mem,
              g_out_lru, g_out_swa, g_out_mem, w_out, g_ffn, w_router, b_router, w1, b1, w2, b2):
    B, S, _ = x.shape
    h = x
    split_at = [D_LRU, 2 * D_LRU, 2 * D_LRU + D_SWA, 2 * D_LRU + D_SWA + D_SWA_KV,
                2 * D_LRU + D_SWA + 2 * D_SWA_KV]
    for l in range(DEPTH):
        xn = rms_norm(h, g_mix[l])
        u = xn @ w_in[l]
        u_lru, u_gate, u_q, u_k, u_v, u_qm = jnp.split(u, split_at, axis=-1)

        xc = causal_depthwise_conv(u_lru, conv_w[l], conv_b[l])
        y_lru = rg_lru(xc, lru_wa[l], lru_ba[l], lru_wx[l], lru_bx[l], lru_lambda[l]) * jax.nn.gelu(u_gate)

        q = rms_norm(u_q.reshape(B, S, N_SWA_HEADS, HEAD_DIM), q_norm_swa[l])
        k = rms_norm(u_k.reshape(B, S, N_SWA_KV, HEAD_DIM), k_norm_swa[l])
        v = u_v.reshape(B, S, N_SWA_KV, HEAD_DIM)
        y_swa = sliding_window_sink_attention(q, k, v, swa_sinks[l])

        mkv = rms_norm(mem, g_mem[l]) @ w_mem_kv[l]
        km = rms_norm(mkv[..., :D_MEM].reshape(B, MEM_LEN, N_MEM_HEADS, HEAD_DIM), k_norm_mem[l])
        vm = mkv[..., D_MEM:].reshape(B, MEM_LEN, N_MEM_HEADS, HEAD_DIM)
        qm = rms_norm(u_qm.reshape(B, S, N_MEM_HEADS, HEAD_DIM), q_norm_mem[l])
        y_mem = memory_cross_attention(qm, km, vm)

        y = jnp.concatenate([rms_norm(y_lru, g_out_lru[l]),
                             rms_norm(y_swa, g_out_swa[l]),
                             rms_norm(y_mem, g_out_mem[l])], axis=-1)
        h = h + y @ w_out[l]

        h = h + moe(rms_norm(h, g_ffn[l]), w_router[l], b_router[l], w1[l], b1[l], w2[l], b2[l])
    return h
```

```cpp
#include <hip/hip_runtime.h>
#include <cstdio>
#include <cstdint>

#ifndef MK_N_LAUNCHES
#define MK_N_LAUNCHES 1
#endif

#define LAS __attribute__((address_space(3)))
#define GAS __attribute__((address_space(1)))
typedef unsigned short bf16;
typedef short bf16x8 __attribute__((ext_vector_type(8)));
typedef float f32x4 __attribute__((ext_vector_type(4)));
typedef float f32x2 __attribute__((ext_vector_type(2)));
typedef unsigned u32x4 __attribute__((ext_vector_type(4)));
typedef unsigned u32x2 __attribute__((ext_vector_type(2)));
typedef GAS unsigned gu32;

constexpr int S = 16384, D = 1024, D_IN = 1664, D_INP = 1792, MEM_LEN = 256;
constexpr int OFF_LRU = 0, OFF_GATE = 384, OFF_Q = 768, OFF_K = 1152, OFF_V = 1280, OFF_QM = 1408;
constexpr int NE = 32, CAP = 16384, MAXMT = 288, FF2 = 2048;
constexpr float EPS = 1e-6f;
constexpr float YSCALE = 8.0f;
constexpr float WSCALE = 64.0f;
constexpr int P8 = 1152;
constexpr int NTILE = S / 64;

constexpr size_t MiB = 1u << 20;
constexpr size_t WS_CTL = 0, CTL_ZERO_BYTES = 1 * MiB;
constexpr size_t WS_WIN = 1 * MiB;
constexpr size_t WS_WOUT = 5 * MiB;
constexpr size_t WS_SMALL = 7 * MiB;
constexpr size_t SM_KM = WS_SMALL;
constexpr size_t SM_VM = SM_KM + 128 * 1024;
constexpr size_t SM_VMT = SM_VM + 128 * 1024;
constexpr size_t SM_WAT = SM_VMT + 128 * 1024;
constexpr size_t SM_WXT = SM_WAT + 64 * 1024;
constexpr size_t SM_AAGG = SM_WXT + 64 * 1024;
constexpr size_t SM_BAGG = SM_AAGG + 384 * 1024;
constexpr size_t SM_RSTD1 = SM_BAGG + 384 * 1024;
constexpr size_t SM_RSTD2 = SM_RSTD1 + 64 * 1024;
constexpr size_t SM_TOKSLOT = SM_RSTD2 + 64 * 1024;
constexpr size_t SM_GATE = SM_TOKSLOT + 256 * 1024;
constexpr size_t SM_SSQP = SM_GATE + 256 * 1024;
constexpr size_t SM_B1P = SM_SSQP + 1024 * 1024;
constexpr size_t SM_LIST = 12 * MiB;
constexpr size_t SM_RSLIST = 14 * MiB;
constexpr size_t SM_CARRY = SM_B1P + 256 * 1024;
constexpr size_t SM_WRH = SM_CARRY + 384 * 1024;
constexpr size_t SM_WRL = SM_WRH + 64 * 1024;
static_assert(SM_WRL + 64 * 1024 <= SM_LIST, "small map");
constexpr size_t WS_XB = 16 * MiB;
constexpr size_t WS_U = 48 * MiB;
constexpr size_t WS_Y = 104 * MiB;
constexpr size_t WS_HB = 136 * MiB;
constexpr size_t WS_YP = 648 * MiB;
constexpr size_t WS_W1 = 168 * MiB;
constexpr size_t WS_W2 = 296 * MiB;
constexpr size_t WS_ACT = 360 * MiB;
constexpr size_t WS_Y2 = 504 * MiB;
constexpr size_t WS_HBF = 672 * MiB;
constexpr size_t WS_END = 704 * MiB;
constexpr int CW_TMO = 0, CW_CODE = 1;
constexpr int CW_BAR = 4096;
constexpr int CW_CNT = 8192;

constexpr int RING_BYTES = 131072;
constexpr int LDSCTL_OFF = RING_BYTES, MISC_OFF = LDSCTL_OFF + 320;
constexpr int TAB_OFF = RING_BYTES + 1024;
constexpr int PTAB_OFF = RING_BYTES + 4096;
constexpr int LDS_BYTES = 147456;

__device__ __forceinline__ unsigned f2bf(float f) { unsigned u = __builtin_bit_cast(unsigned, f); return (u + 0x7fffu + ((u >> 16) & 1u)) >> 16; }
__device__ __forceinline__ unsigned pk2(float lo, float hi) { return f2bf(lo) | (f2bf(hi) << 16); }
__device__ __forceinline__ float bflo(unsigned w) { return __uint_as_float(w << 16); }
__device__ __forceinline__ float bfhi(unsigned w) { return __uint_as_float(w & 0xffff0000u); }
__device__ __forceinline__ float bf1(bf16 b) { return __uint_as_float(((unsigned)b) << 16); }
#define LDS_WAIT() asm volatile("s_waitcnt lgkmcnt(0)" ::: "memory")
#define VM_WAIT() asm volatile("s_waitcnt vmcnt(0)" ::: "memory")
#define RLX_AGENT __ATOMIC_RELAXED, __HIP_MEMORY_SCOPE_AGENT

namespace pg8 {
#define PG8_LAS __attribute__((address_space(3)))
constexpr int BM = 256, BK = 64, HALF = 128, HTB = HALF * BK * 2, STAGE_BYTES = 8 * HTB, NXCD = 8, WGM = 8, KD = 1024;
typedef int i32x4 __attribute__((ext_vector_type(4)));
typedef int i32x8 __attribute__((ext_vector_type(8)));
__device__ __forceinline__ float fp8_sat(float x) { return __builtin_fminf(__builtin_fmaxf(x, -448.0f), 448.0f); }
__device__ __forceinline__ unsigned pk4_fp8(float a, float b, float c, float d) { int w = 0; w = __builtin_amdgcn_cvt_pk_fp8_f32(fp8_sat(a), fp8_sat(b), w, false); w = __builtin_amdgcn_cvt_pk_fp8_f32(fp8_sat(c), fp8_sat(d), w, true); return (unsigned)w; }
constexpr int W2_PASSES = 32 * 16 * 32, W1_PASSES = 32 * 16 * 64, W2SCR_OFF = 131072 + 6144, W2SCR_WAVE = 1280;
template <bool IS1> __device__ __forceinline__ void wq_pass_load(f32x4 (&v)[2][4], const float* w, int q, int lane) {
    constexpr int N = IS1 ? 2048 : 1024, NBL = IS1 ? 6 : 5;
    const int e = q >> (4 + NBL), rem = q & ((16 << NBL) - 1), kb = rem >> NBL, nb = rem & ((1 << NBL) - 1); const float* W = w + (size_t)e * 1024 * N + (size_t)(64 * kb) * N + 32 * nb + 4 * (lane & 7);
#pragma unroll
    for (int grp = 0; grp < 2; ++grp)
#pragma unroll
        for (int ee = 0; ee < 4; ++ee) v[grp][ee] = __builtin_nontemporal_load((const f32x4*)(W + (size_t)(32 * grp + 4 * (lane >> 3) + ee) * N));
}
template <bool IS1> __device__ __forceinline__ void wq_pass_emit(const f32x4 (&v)[2][4], unsigned char* wt, int q, PG8_LAS unsigned char* scr, int lane, float scale) {
    constexpr int N = IS1 ? 2048 : 1024, NBL = IS1 ? 6 : 5;
    const int e = q >> (4 + NBL), rem = q & ((16 << NBL) - 1), kb = rem >> NBL, nb = rem & ((1 << NBL) - 1), r = lane >> 3, c = lane & 7;
    unsigned w[4][2];
#pragma unroll
    for (int comp = 0; comp < 4; ++comp)
#pragma unroll
        for (int grp = 0; grp < 2; ++grp) w[comp][grp] = pk4_fp8(v[grp][0][comp] * scale, v[grp][1][comp] * scale, v[grp][2][comp] * scale, v[grp][3][comp] * scale);
    unsigned char* dst = wt + (size_t)e * N * P8 + 64 * kb;
#pragma unroll
    for (int hh = 0; hh < 2; ++hh) {
        if ((c >> 2) == hh) {
#pragma unroll
            for (int comp = 0; comp < 4; ++comp)
#pragma unroll
                for (int grp = 0; grp < 2; ++grp) *(PG8_LAS unsigned*)(scr + (4 * (c & 3) + comp) * 80 + (8 * grp + r) * 4) = w[comp][grp];
        }
        asm volatile("s_waitcnt lgkmcnt(0)" ::: "memory");
        const u32x4 o = *(const PG8_LAS u32x4*)(scr + (lane >> 2) * 80 + (lane & 3) * 16);
        int nn = 32 * nb + 16 * hh + (lane >> 2); if (IS1) { const int a = nn >> 1, s1 = nn & 1; nn = 256 * (a >> 7) + 128 * s1 + (a & 127); }
        *(u32x4*)(dst + (size_t)nn * P8 + 16 * (lane & 3)) = o;
        asm volatile("s_waitcnt lgkmcnt(0)" ::: "memory");
    }
}
__device__ __forceinline__ void w2_pass_load(f32x4 (&v)[2][4], const float* w2, int q, int lane) { wq_pass_load<false>(v, w2, q, lane); }
__device__ __forceinline__ void w2_pass_load_grp(f32x4 (&v)[2][4], const float* w2, int q, int lane, int grp) {
    const int e = q >> 9, rem = q & 511, kb = rem >> 5, nb = rem & 31; const float* W = w2 + (size_t)e * 1024 * 1024 + (size_t)(64 * kb) * 1024 + 32 * nb + 4 * (lane & 7);
#pragma unroll
    for (int ee = 0; ee < 4; ++ee) v[grp][ee] = __builtin_nontemporal_load((const f32x4*)(W + (size_t)(32 * grp + 4 * (lane >> 3) + ee) * 1024));
}
__device__ __forceinline__ void w2_pass_emit(const f32x4 (&v)[2][4], unsigned char* w2t, int q, PG8_LAS unsigned char* scr, int lane, float scale) { wq_pass_emit<false>(v, w2t, q, scr, lane, scale); }
struct W1Rider { const float* w1; unsigned char* w1t; PG8_LAS unsigned char* scr; int q, qstep, qlive, qend; f32x4 v[2][4];
    __device__ __forceinline__ void init(const float* w1_, unsigned char* w1t_, PG8_LAS unsigned char* lds, int gw, int ngw, int wid, int j0, int j1, int qcap) { w1 = w1_; w1t = w1t_; scr = lds + W2SCR_OFF + wid * W2SCR_WAVE; q = gw + ngw * j0; qstep = ngw; qlive = -1; const long long e = (long long)gw + (long long)ngw * j1; qend = e < qcap ? (int)e : qcap; }
    __device__ __forceinline__ void init_x(const float* w1_, unsigned char* w1t_, PG8_LAS unsigned char* lds, int wid, int q0, int step, int qe) { w1 = w1_; w1t = w1t_; scr = lds + W2SCR_OFF + wid * W2SCR_WAVE; q = q0; qstep = step; qlive = -1; qend = qe; }
    __device__ __forceinline__ void issue(int lane) { if (q < qend) { wq_pass_load<true>(v, w1, q, lane); qlive = q; q += qstep; } else qlive = -1; }
    __device__ __forceinline__ void retire(int lane) { if (qlive >= 0) wq_pass_emit<true>(v, w1t, qlive, scr, lane, WSCALE); qlive = -1; }
    __device__ __forceinline__ void ride(int lane) { if (qlive >= 0) wq_pass_emit<true>(v, w1t, qlive, scr, lane, WSCALE); if (q < qend) { wq_pass_load<true>(v, w1, q, lane); qlive = q; q += qstep; } else qlive = -1; }
    __device__ __forceinline__ void drain(int lane) { if (qlive < 0) ride(lane); while (qlive >= 0) ride(lane); }
    __device__ __forceinline__ void drain3(int lane) {
        retire(lane);
        f32x4 va[2][4], vb[2][4]; int qa = -1, qb = -1, qc = -1;
        if (q < qend) { qa = q; q += qstep; wq_pass_load<true>(va, w1, qa, lane); }
        if (q < qend) { qb = q; q += qstep; wq_pass_load<true>(vb, w1, qb, lane); }
        while (qa >= 0) {
            if (q < qend) { qc = q; q += qstep; wq_pass_load<true>(v, w1, qc, lane); } else qc = -1;
            wq_pass_emit<true>(va, w1t, qa, scr, lane, WSCALE);
#pragma unroll
            for (int g2 = 0; g2 < 2; ++g2)
#pragma unroll
                for (int e2 = 0; e2 < 4; ++e2) { va[g2][e2] = vb[g2][e2]; vb[g2][e2] = v[g2][e2]; }
            qa = qb; qb = qc;
        }
    }
};
__host__ __device__ __forceinline__ int lds_byte(int r, int c) { const int st = (r >> 4) * 2 + (c >> 5), rr = r & 15, cc = c & 31, ob = rr * 64 + cc * 2; return st * 1024 + (ob ^ (((ob >> 9) & 1) << 5)); }
__host__ __device__ __forceinline__ void stage_rc(int b, int& R, int& C) { const int st = b / 1024, sb = b % 1024, swz = sb ^ (((sb >> 9) & 1) << 5); R = (st >> 1) * 16 + swz / 64; C = (st & 1) * 32 + (swz % 64) / 2; }
__host__ __device__ __forceinline__ int perm32(int rho) { const int n = rho >> 4, i = rho & 15; return 8 * (i >> 2) + 4 * n + (i & 3); }
__device__ __forceinline__ unsigned cvt_pk_bf16(float lo, float hi) { unsigned r; asm volatile("v_cvt_pk_bf16_f32 %0, %1, %2" : "=v"(r) : "v"(lo), "v"(hi)); return r; }

struct Unit { int pm, pn, e, rowbase; };

struct SchedDense {
    int nM, nN, nwg, G, c; const bf16* Bt; unsigned Bbytes;
    __device__ void init(int M, int N, int G_, int c_, const bf16* Bt_) { nM = M / BM; nN = N / BM; nwg = nM * nN; G = G_; c = c_; Bt = Bt_; Bbytes = (unsigned)N * KD * 2; }
    __device__ bool next(int i, Unit& u) const {
        const long L = (long)i * G + c; if (L >= nwg) return false;
        int wgid = (int)L; { const int q = nwg / NXCD, r = nwg % NXCD, xcd = wgid % NXCD, off = wgid / NXCD; wgid = (xcd < r ? xcd * (q + 1) : r * (q + 1) + (xcd - r) * q) + off; }
        const int nig = WGM * nN, gid = wgid / nig, fm = gid * WGM, gsz = (nM - fm) < WGM ? (nM - fm) : WGM;
        u.pm = fm + ((wgid % nig) % gsz); u.pn = (wgid % nig) / gsz; u.e = 0; u.rowbase = u.pm * BM; return true;
    }
    __device__ __forceinline__ unsigned arow(const Unit& u, int r) const { return (unsigned)(u.pm * BM + r); }
    __device__ __forceinline__ unsigned bbase(const Unit& u) const { return (unsigned)u.pn * (unsigned)(BM * KD * 2); }
    static constexpr bool GATHER = false;
    __device__ __forceinline__ unsigned abase(const Unit& u) const { return (unsigned)u.rowbase; }
};
template <bool GATHER_> struct SchedMoE {
    static constexpr bool GATHER = GATHER_;
    __device__ __forceinline__ unsigned abase(const Unit& u) const { return (unsigned)u.rowbase; }
    int NT, G, c, ntot; const bf16* Bt; unsigned Bbytes; unsigned estride;
    const PG8_LAS int* cnt; const PG8_LAS int* tile_start; const PG8_LAS int* row_start; const PG8_LAS int* mt_expert;
    const unsigned* list;
    __device__ bool next(int i, Unit& u) const {
        int mtg;
        if (G == 256) {
            const int x = c & 7, q = c >> 3, nsub = NT >> 2, item = i * 8 + x, chunk = item / nsub, hlf = item - chunk * nsub;
            mtg = chunk * 8 + (q & 7); u.pn = hlf * 4 + (q >> 3);
            if (mtg * NT >= ntot) return false;
        } else { const int L = i * G + c; if (L >= ntot) return false; mtg = L / NT; u.pn = L - mtg * NT; } u.e = __builtin_amdgcn_readfirstlane(mt_expert[mtg]); u.pm = mtg - __builtin_amdgcn_readfirstlane(tile_start[u.e]); u.rowbase = __builtin_amdgcn_readfirstlane(row_start[u.e]) + u.pm * BM; return true;
    }
    __device__ __forceinline__ unsigned arow(const Unit& u, int r) const {
        const int pos = min(u.pm * BM + r, cnt[u.e] - 1); return list[(size_t)u.e * CAP + pos];
    }
    __device__ __forceinline__ unsigned bbase(const Unit& u) const { return (unsigned)u.e * estride + (unsigned)u.pn * (unsigned)(BM * P8); }
};

struct EpiInProj {
    static constexpr bool LDSEPI = false;
    static constexpr bool RIDER = false;
    static constexpr bool PERM = true, FP8 = false;
    bf16* U; const float* rstd;
    __device__ __forceinline__ void operator()(const f32x4 (&acc)[2][2][4][2], const Unit& u, int wr, int wc, int fr, int fq) const {
        const int row0 = u.rowbase + wr * 64 + fr, col0 = u.pn * BM + wc * 32 + 8 * fq;
#pragma unroll
        for (int ai = 0; ai < 2; ++ai)
#pragma unroll
            for (int m = 0; m < 4; ++m) { const int row = row0 + ai * HALF + m * 16; const float rs = rstd[row]; bf16* rowp = U + (size_t)row * D_INP + col0;
#pragma unroll
                for (int bj = 0; bj < 2; ++bj) { const f32x4 v0 = acc[ai][bj][m][0] * rs, v1 = acc[ai][bj][m][1] * rs;
                    u32x4 w; w.x = cvt_pk_bf16(v0[0], v0[1]); w.y = cvt_pk_bf16(v0[2], v0[3]); w.z = cvt_pk_bf16(v1[0], v1[1]); w.w = cvt_pk_bf16(v1[2], v1[3]);
                    *(u32x4*)(rowp + bj * HALF) = w; } }
    }
};
struct EpiOutProj {
    static constexpr bool LDSEPI = false;
    static constexpr bool RIDER = false;
    static constexpr bool PERM = true, FP8 = false;
    const float* x; bf16* hbf; unsigned char* HB8; float* ssqp; const float* gffn;
    __device__ __forceinline__ void operator()(const f32x4 (&acc)[2][2][4][2], const Unit& u, int wr, int wc, int fr, int fq) const {
        const int row0 = u.rowbase + wr * 64 + fr, col0 = u.pn * BM + wc * 32 + 8 * fq;
        f32x4 gf[2][2];
#pragma unroll
        for (int bj = 0; bj < 2; ++bj) { gf[bj][0] = *(const f32x4*)(gffn + col0 + bj * HALF); gf[bj][1] = *(const f32x4*)(gffn + col0 + bj * HALF + 4); }
#pragma unroll
        for (int ai = 0; ai < 2; ++ai)
#pragma unroll
            for (int m = 0; m < 4; ++m) { const int row = row0 + ai * HALF + m * 16; const size_t off = (size_t)row * D + col0; float sq = 0.f;
#pragma unroll
                for (int bj = 0; bj < 2; ++bj) { const size_t o = off + bj * HALF; const f32x4 h0 = __builtin_nontemporal_load((const f32x4*)(x + o)) + acc[ai][bj][m][0], h1 = __builtin_nontemporal_load((const f32x4*)(x + o + 4)) + acc[ai][bj][m][1];
                    { u32x4 hw; hw.x = cvt_pk_bf16(h0[0], h0[1]); hw.y = cvt_pk_bf16(h0[2], h0[3]); hw.z = cvt_pk_bf16(h1[0], h1[1]); hw.w = cvt_pk_bf16(h1[2], h1[3]); *(u32x4*)(hbf + o) = hw; } const f32x4 s0 = h0 * gf[bj][0], s1 = h1 * gf[bj][1]; u32x2 w; w.x = pk4_fp8(s0[0], s0[1], s0[2], s0[3]); w.y = pk4_fp8(s1[0], s1[1], s1[2], s1[3]); *(u32x2*)(HB8 + (size_t)row * P8 + col0 + bj * HALF) = w;
                    sq += ((h0[0] * h0[0] + h0[1] * h0[1]) + (h0[2] * h0[2] + h0[3] * h0[3])) + ((h1[0] * h1[0] + h1[1] * h1[1]) + (h1[2] * h1[2] + h1[3] * h1[3])); }
                sq += __shfl_xor(sq, 16); sq += __shfl_xor(sq, 32);
                if (fq == 0) ssqp[(size_t)row * 16 + u.pn * 4 + wc] = sq; }
    }
};
struct EpiMoE1 {
    static constexpr bool LDSEPI = false;
    static constexpr bool RIDER = true; const float* w2; unsigned char* w2t;
    static constexpr bool PERM = true, FP8 = true;
    unsigned char* ACT; const float* b1p; const float* rslist; const PG8_LAS int* cnt;
    __device__ __forceinline__ void operator()(const f32x4 (&acc)[2][2][4][2], const Unit& u, int wr, int wc, int fr, int fq) const { half(acc, u, wr, wc, fr, fq, 0); half(acc, u, wr, wc, fr, fq, 1); }
    __device__ __forceinline__ void half(const f32x4 (&acc)[2][2][4][2], const Unit& u, int wr, int wc, int fr, int fq, const int ai) const {
        const int r0 = wr * 64 + fr, cb = wc * 32 + 8 * fq; const int last = cnt[u.e] - 1 - u.pm * BM;
        const float* bp = b1p + (size_t)u.e * FF2 + u.pn * BM + cb; const float* rsp = rslist + (size_t)u.e * CAP + u.pm * BM;
        const f32x4 bg0 = *(const f32x4*)(bp), bg1 = *(const f32x4*)(bp + 4), bl0 = *(const f32x4*)(bp + HALF), bl1 = *(const f32x4*)(bp + HALF + 4);
        float rsv[4];
#pragma unroll
        for (int m = 0; m < 4; ++m) rsv[m] = rsp[min(r0 + ai * HALF + m * 16, last)] * (1.0f / WSCALE);
#pragma unroll
            for (int m = 0; m < 4; ++m) { const int r = r0 + ai * HALF + m * 16; const float rs = rsv[m];
                const f32x4 g0 = acc[ai][0][m][0] * rs + bg0, g1 = acc[ai][0][m][1] * rs + bg1, l0 = acc[ai][1][m][0] * rs + bl0, l1 = acc[ai][1][m][1] * rs + bl1;
                float o[8];
#pragma unroll
                for (int j = 0; j < 8; ++j) { const float g = fminf(j < 4 ? g0[j & 3] : g1[j & 3], 7.0f); const float l = fminf(fmaxf(j < 4 ? l0[j & 3] : l1[j & 3], -7.0f), 7.0f);
                    o[j] = g * __builtin_amdgcn_rcpf(1.0f + __expf(-1.702f * g)) * (l + 1.0f); }
                u32x2 w; w.x = pk4_fp8(o[0], o[1], o[2], o[3]); w.y = pk4_fp8(o[4], o[5], o[6], o[7]);
                *(u32x2*)(ACT + (size_t)(u.rowbase + r) * P8 + u.pn * HALF + cb) = w; }
    }
};
struct EpiMoE2 {
    static constexpr bool PERM = true, FP8 = true;
    static constexpr int RIDER = 0; static constexpr bool LDSEPI = true;
    unsigned char* Y2; const float* b2;
    __device__ __forceinline__ void operator()(const f32x4 (&acc)[2][2][4][2], const Unit& u, int wr, int wc, int fr, int fq, PG8_LAS unsigned char* lds, int tid) const {
        PG8_LAS unsigned char* buf = lds + 3 * HTB;
        const int col0 = u.pn * BM + wc * 32 + 8 * fq;
        f32x4 bv[2][2];
#pragma unroll
        for (int bj = 0; bj < 2; ++bj)
#pragma unroll
            for (int n = 0; n < 2; ++n) bv[bj][n] = *(const f32x4*)(b2 + (size_t)u.e * D + col0 + bj * HALF + 4 * n) * YSCALE;
#pragma unroll
        for (int s = 0; s < 4; ++s) {
            const int ai = s >> 1;
            if (wr == (s & 1)) {
#pragma unroll
                for (int m = 0; m < 4; ++m) { const int row = 16 * m + fr;
#pragma unroll
                    for (int bj = 0; bj < 2; ++bj) { const f32x4 v0 = acc[ai][bj][m][0] * (YSCALE / WSCALE) + bv[bj][0], v1 = acc[ai][bj][m][1] * (YSCALE / WSCALE) + bv[bj][1];
                        u32x2 w; w.x = pk4_fp8(v0[0], v0[1], v0[2], v0[3]); w.y = pk4_fp8(v1[0], v1[1], v1[2], v1[3]);
                        const int ch = 8 * bj + 2 * wc + (fq >> 1);
                        *(PG8_LAS u32x2*)(buf + row * 256 + ((ch ^ fr) << 4) + 8 * (fq & 1)) = w; } }
            }
            asm volatile("s_waitcnt lgkmcnt(0)" ::: "memory"); __builtin_amdgcn_s_barrier(); asm volatile("" ::: "memory");
#pragma unroll
            for (int k = 0; k < 2; ++k) { const int ci = tid + 512 * k, row = ci >> 4, ch = ci & 15;
                const u32x4 o = *(const PG8_LAS u32x4*)(buf + row * 256 + ((ch ^ (row & 15)) << 4));
                __builtin_nontemporal_store(o, (u32x4*)(Y2 + (size_t)(u.rowbase + 64 * s + row) * D + u.pn * BM + 16 * ch)); }
            asm volatile("s_waitcnt lgkmcnt(0)" ::: "memory"); __builtin_amdgcn_s_barrier(); asm volatile("" ::: "memory");
        }
    }
};

template <class Epi, class Sched>
__device__ __forceinline__ void gemm_phase(PG8_LAS unsigned char* lds, const bf16* Abase, unsigned Abytes, const Sched& S, const Epi& E) {
    int tid = threadIdx.x; asm volatile("" : "+v"(tid));
    const int wid = __builtin_amdgcn_readfirstlane(tid >> 6), lane = tid & 63, wr = wid >> 2, wc = wid & 3, fr = lane & 15, fq = lane >> 4;
    constexpr bool FP8 = Epi::FP8; constexpr int PITCH = FP8 ? P8 : KD * 2; constexpr int nt = FP8 ? KD / 128 : KD / BK;
    int R0, C0; stage_rc(tid * 16, R0, C0);
    unsigned voffB[2];
#pragma unroll
    for (int i = 0; i < 2; ++i) { const int R = R0 + 64 * i; const int Rb = Epi::PERM ? ((R & ~31) + perm32(R & 31)) : R; voffB[i] = (unsigned)(Rb * PITCH + C0 * 2); }
    constexpr unsigned kstep = (unsigned)(BK * 2);
    constexpr unsigned hstep = (unsigned)HALF * PITCH;
    const unsigned ldsw = (unsigned)wid * 1024u;
    const int aoff = lds_byte(wr * 64 + fr, fq * 8), boff = lds_byte(wc * 32 + fr, fq * 8);
    const __amdgpu_buffer_rsrc_t rsA = __builtin_amdgcn_make_buffer_rsrc((void*)Abase, (short)0, (int)Abytes, 0x00020000);
    const __amdgpu_buffer_rsrc_t rsB = __builtin_amdgcn_make_buffer_rsrc((void*)S.Bt, (short)0, (int)S.Bbytes, 0x00020000);
#define PG8_SA(b, h) (((b) * 2 + (h)) * HTB)
#define PG8_SB(b, h) ((4 + (b) * 2 + (h)) * HTB)
#define PG8_STAGE(bufoff, soff, voff) do { _Pragma("unroll") for (int _i = 0; _i < 2; ++_i) \
        __builtin_amdgcn_raw_ptr_buffer_load_lds(rsB, (PG8_LAS void*)(lds + (bufoff) + ldsw + _i * 8192), 16, (int)(voff)[_i], (int)(soff), 0, 0); } while (0)
#define PG8_STAGEA(bufoff, H, kb, NEXT) do { \
        if constexpr (Sched::GATHER) { const unsigned _tk = (NEXT) ? ((H) ? nt1 : nt0) : ((H) ? ct1 : ct0); \
            __builtin_amdgcn_raw_ptr_buffer_load_lds(rsA, (PG8_LAS void*)(lds + (bufoff) + ldsw), 16, (int)((_tk & 0xffffu) * (unsigned)PITCH + (unsigned)(C0 * 2)), (int)(kb), 0, 0); \
            __builtin_amdgcn_raw_ptr_buffer_load_lds(rsA, (PG8_LAS void*)(lds + (bufoff) + ldsw + 8192), 16, (int)((_tk >> 16) * (unsigned)PITCH + (unsigned)(C0 * 2)), (int)(kb), 0, 0); } \
        else { const unsigned _sb = ((NEXT) ? nA : cA) + (H) * hstep + (kb); \
            __builtin_amdgcn_raw_ptr_buffer_load_lds(rsA, (PG8_LAS void*)(lds + (bufoff) + ldsw), 16, (int)voffA0, (int)_sb, 0, 0); \
            __builtin_amdgcn_raw_ptr_buffer_load_lds(rsA, (PG8_LAS void*)(lds + (bufoff) + ldsw + 8192), 16, (int)voffA0, (int)(_sb + 64u * PITCH), 0, 0); } } while (0)
#define PG8_LDA(dst, b, h) do { _Pragma("unroll") for (int m = 0; m < 4; ++m) _Pragma("unroll") for (int k = 0; k < 2; ++k) dst[m][k] = *(const PG8_LAS bf16x8*)(lds + PG8_SA(b, h) + aoff + m * 2048 + k * 1024); } while (0)
#define PG8_LDB(dst, b, h) do { _Pragma("unroll") for (int n = 0; n < 2; ++n) _Pragma("unroll") for (int k = 0; k < 2; ++k) dst[n][k] = *(const PG8_LAS bf16x8*)(lds + PG8_SB(b, h) + boff + n * 2048 + k * 1024); } while (0)
#define PG8_CAT(f) __builtin_shufflevector(__builtin_bit_cast(i32x4, (f)[0]), __builtin_bit_cast(i32x4, (f)[1]), 0, 1, 2, 3, 4, 5, 6, 7)
#define PG8_MMA(ai, bj, At, Bt) do { __builtin_amdgcn_s_setprio(1); _Pragma("unroll") for (int m = 0; m < 4; ++m) _Pragma("unroll") for (int n = 0; n < 2; ++n) { \
        if constexpr (FP8) { const i32x8 _b = PG8_CAT(Bt[n]), _a = PG8_CAT(At[m]); asm volatile("v_mfma_scale_f32_16x16x128_f8f6f4 %0, %1, %2, %0, %3, %3 op_sel_hi:[0,0,0]" : "+v"(acc[ai][bj][m][n]) : "v"(_b), "v"(_a), "v"(scale1)); }   \
        else { _Pragma("unroll") for (int k = 0; k < 2; ++k) acc[ai][bj][m][n] = __builtin_amdgcn_mfma_f32_16x16x32_bf16(Bt[n][k], At[m][k], acc[ai][bj][m][n], 0, 0, 0); } } \
        __builtin_amdgcn_s_setprio(0); } while (0)
#define PG8_WAIT_V(n) asm volatile("s_waitcnt vmcnt(" #n ")" ::: "memory")
#define PG8_WAIT_L(n) asm volatile("s_waitcnt lgkmcnt(" #n ")" ::: "memory")
#define PG8_BAR __builtin_amdgcn_s_barrier()
#define PG8_SCHED __builtin_amdgcn_sched_barrier(0)
#define PG8_TOK2(u, h) (S.arow(u, (h) * HALF + R0) | (S.arow(u, (h) * HALF + R0 + 64) << 16))
    Unit cur, nxt; int ui = 0;
    if (!S.next(0, cur)) {
        if constexpr (Epi::RIDER) { for (int u2 = 0; ; ++u2) { const int q = (u2 * (int)gridDim.x + (int)blockIdx.x) * 8 + wid; if (q >= W2_PASSES) break;
            f32x4 rv[2][4]; w2_pass_load(rv, E.w2, q, lane); w2_pass_emit(rv, E.w2t, q, lds + W2SCR_OFF + wid * W2SCR_WAVE, lane, WSCALE); } }
        return; }
    f32x4 acc[2][2][4][2];
#pragma unroll
    for (int a = 0; a < 2; ++a)
#pragma unroll
        for (int b = 0; b < 2; ++b)
#pragma unroll
            for (int m = 0; m < 4; ++m)
#pragma unroll
                for (int n = 0; n < 2; ++n) acc[a][b][m][n] = (f32x4){0.f, 0.f, 0.f, 0.f};
    bf16x8 At[4][2], B0[2][2], B1[2][2];
    const int scale1 = 0x7F7F7F7F;
    const unsigned voffA0 = (unsigned)(R0 * PITCH + C0 * 2);
    unsigned ct0 = 0, ct1 = 0, nt0 = 0, nt1 = 0, cA = 0, nA = 0;
    if constexpr (Sched::GATHER) { ct0 = PG8_TOK2(cur, 0); ct1 = PG8_TOK2(cur, 1); } else cA = S.abase(cur) * (unsigned)PITCH;
    unsigned cB = S.bbase(cur);
    PG8_STAGE(PG8_SB(0, 0), cB, voffB); PG8_STAGE(PG8_SB(0, 1), cB + hstep, voffB); PG8_STAGEA(PG8_SA(0, 0), 0, 0u, false); PG8_STAGEA(PG8_SA(0, 1), 1, 0u, false);
    if (wr == 1) PG8_BAR;
    PG8_WAIT_V(2); PG8_BAR;
    PG8_STAGE(PG8_SB(1, 0), cB + kstep, voffB); PG8_STAGEA(PG8_SA(1, 0), 0, kstep, false); PG8_STAGE(PG8_SB(1, 1), cB + hstep + kstep, voffB);
    PG8_WAIT_V(6); PG8_BAR;
    for (;;) {
        const bool has_next = S.next(ui + 1, nxt);
        const unsigned nB = has_next ? S.bbase(nxt) : cB;
#define PG8_KBODY(LAST, t) do { \
            const unsigned kb1 = (unsigned)((t) + 1) * kstep; \
            const unsigned kb2 = (LAST) ? 0u : (unsigned)((t) + 2) * kstep; \
            const unsigned b2 = (LAST) ? nB : cB + (unsigned)((t) + 2) * kstep; const unsigned b3 = b2 + kstep; \
              \
            PG8_LDB(B0, 0, 0); PG8_LDB(B1, 0, 1); PG8_SCHED; PG8_LDA(At, 0, 0); PG8_STAGEA(PG8_SA(1, 1), 1, kb1, false); \
            PG8_WAIT_V(8); PG8_WAIT_L(0); PG8_BAR; PG8_MMA(0, 0, At, B0); PG8_MMA(0, 1, At, B1); PG8_BAR; PG8_SCHED; \
              \
            PG8_LDA(At, 0, 1); PG8_STAGE(PG8_SB(0, 0), b2, voffB); PG8_STAGE(PG8_SB(0, 1), b2 + hstep, voffB); PG8_STAGEA(PG8_SA(0, 0), 0, kb2, (LAST)); \
            PG8_WAIT_V(8); PG8_WAIT_L(0); PG8_BAR; PG8_MMA(1, 0, At, B0); PG8_MMA(1, 1, At, B1); PG8_BAR; PG8_SCHED; \
              \
            PG8_LDB(B0, 1, 0); PG8_LDB(B1, 1, 1); PG8_SCHED; PG8_LDA(At, 1, 0); PG8_STAGEA(PG8_SA(0, 1), 1, kb2, (LAST)); \
            PG8_WAIT_V(8); PG8_WAIT_L(0); PG8_BAR; PG8_MMA(0, 0, At, B0); PG8_MMA(0, 1, At, B1); PG8_BAR; PG8_SCHED; \
              \
            PG8_LDA(At, 1, 1); PG8_STAGE(PG8_SB(1, 0), b3, voffB); PG8_STAGE(PG8_SB(1, 1), b3 + hstep, voffB); PG8_STAGEA(PG8_SA(1, 0), 0, kb2 + kstep, (LAST)); \
            PG8_WAIT_V(8); PG8_WAIT_L(0); PG8_BAR; PG8_MMA(1, 0, At, B0); PG8_MMA(1, 1, At, B1); PG8_BAR; PG8_SCHED; \
        } while (0)
#pragma unroll 1
        for (int t = 0; t < nt; t += 2) {
            const bool last = (t == nt - 2);
            if (last) { if constexpr (Sched::GATHER) { if (has_next) { nt0 = PG8_TOK2(nxt, 0); nt1 = PG8_TOK2(nxt, 1); } else { nt0 = ct0; nt1 = ct1; } } else nA = has_next ? S.abase(nxt) * (unsigned)PITCH : cA; }
            PG8_KBODY(last, t);
        }
        if constexpr (FP8) asm volatile("s_nop 15\n\ts_nop 15\n\ts_nop 7" ::: "memory");
        if (wr == 0) PG8_BAR;
        if constexpr (Epi::RIDER) {
            int tl = tid; asm volatile("" : "+v"(tl)); const int ln = tl & 63; const int q = (ui * (int)gridDim.x + (int)blockIdx.x) * 8 + wid;
            f32x4 rv[2][4]; const bool ride = q < W2_PASSES;
            if (ride) w2_pass_load_grp(rv, E.w2, q, ln, 0);
            E.half(acc, cur, wr, wc, tl & 15, (tl & 63) >> 4, 0);
            if (ride) w2_pass_load_grp(rv, E.w2, q, ln, 1);
            E.half(acc, cur, wr, wc, tl & 15, (tl & 63) >> 4, 1);
            if (ride) w2_pass_emit(rv, E.w2t, q, lds + W2SCR_OFF + wid * W2SCR_WAVE, ln, WSCALE);
        } else
        { int tl = tid; asm volatile("" : "+v"(tl)); if constexpr (Epi::LDSEPI) E(acc, cur, wr, wc, tl & 15, (tl & 63) >> 4, lds, tl); else E(acc, cur, wr, wc, tl & 15, (tl & 63) >> 4); }
        if (!has_next) break;
#pragma unroll
        for (int a = 0; a < 2; ++a)
#pragma unroll
            for (int b = 0; b < 2; ++b)
#pragma unroll
                for (int m = 0; m < 4; ++m)
#pragma unroll
                    for (int n = 0; n < 2; ++n) acc[a][b][m][n] = (f32x4){0.f, 0.f, 0.f, 0.f};
        cur = nxt; cB = nB; ct0 = nt0; ct1 = nt1; cA = nA; ++ui;
        if (wr == 1) PG8_BAR;
    }
    PG8_WAIT_V(0);
    PG8_BAR;
    if constexpr (Epi::RIDER) {
        for (int u2 = ui + 1; ; ++u2) { const int q = (u2 * (int)gridDim.x + (int)blockIdx.x) * 8 + wid; if (q >= W2_PASSES) break;
            f32x4 rv[2][4]; w2_pass_load(rv, E.w2, q, lane); w2_pass_emit(rv, E.w2t, q, lds + W2SCR_OFF + wid * W2SCR_WAVE, lane, WSCALE); }
    }
#undef PG8_SA
#undef PG8_SB
#undef PG8_STAGE
#undef PG8_STAGEA
#undef PG8_LDA
#undef PG8_LDB
#undef PG8_MMA
#undef PG8_CAT
#undef PG8_WAIT_V
#undef PG8_WAIT_L
#undef PG8_BAR
#undef PG8_SCHED
#undef PG8_TOK2
#undef PG8_KBODY
}
}

#define XB_TMO      128
#define XB_XCNT(j)  (256  + 64 * (j))
#define XB_XSUB(j)  (1280 + 64 * (j))
#define XB_XGEN(j)  (2304 + 64 * (j))
#define XB_TOP      3328
#define XB_TOPGEN   3392
#define XCD_BAR_WORDS 3456
#define XB_SPIN_CAP (1u << 18)
__device__ __forceinline__ unsigned xb_ld(unsigned* p)              { return __hip_atomic_load(p, __ATOMIC_RELAXED, __HIP_MEMORY_SCOPE_AGENT); }
__device__ __forceinline__ unsigned xb_add(unsigned* p, unsigned v) { return __hip_atomic_fetch_add(p, v, __ATOMIC_RELAXED, __HIP_MEMORY_SCOPE_AGENT); }
__device__ __forceinline__ unsigned xb_xcc_id() { return (unsigned)__builtin_amdgcn_s_getreg((3 << 11) | 20) & 0xFu; }
#define XB_SPIN(cond, bar) do { unsigned _sp = 0; while (cond) { __builtin_amdgcn_s_sleep(1); \
    if ((++_sp & 255u) == 0u) { if (xb_ld(&(bar)[XB_TMO])) break; if (_sp > XB_SPIN_CAP) { atomicAdd(&(bar)[XB_TMO], 1u); break; } } } } while (0)
struct XcdBarrier { unsigned* bar; unsigned x; volatile LAS unsigned* st; };
__device__ __forceinline__ XcdBarrier xcd_barrier_post(unsigned* bar, volatile LAS unsigned* st) {
    XcdBarrier b; b.bar = bar; b.x = xb_xcc_id(); b.st = st;
    if (threadIdx.x == 0) (void)xb_add(&bar[XB_XCNT(b.x)], 1u);
    return b;
}
__device__ __forceinline__ void xcd_barrier_complete(unsigned* bar, unsigned x, unsigned& nloc, unsigned& nx) {
    const unsigned G = gridDim.x * gridDim.y * gridDim.z;
    unsigned sum, cnt, mine, sp = 0u;
    for (;;) {
        sum = 0u; cnt = 0u; mine = 0u;
#pragma unroll
        for (unsigned j = 0; j < 16; ++j) { const unsigned c = xb_ld(&bar[XB_XCNT(j)]); sum += c; cnt += (c > 0u) ? 1u : 0u; mine = (j == x) ? c : mine; }
        if (sum == G) break;
        __builtin_amdgcn_s_sleep(1);
        if ((++sp & 255u) == 0u) { if (xb_ld(&bar[XB_TMO])) break; if (sp > XB_SPIN_CAP) { atomicAdd(&bar[XB_TMO], 1u); break; } }
    }
    nloc = mine > 0u ? mine : 1u; nx = cnt > 0u ? cnt : 1u;
}
__device__ __forceinline__ void xcd_barrier(const XcdBarrier& b) {
    asm volatile("s_waitcnt vmcnt(0)" ::: "memory");
    __syncthreads();
    if (threadIdx.x == 0) {
        unsigned* bar = b.bar;
        __builtin_amdgcn_s_waitcnt(0);
        unsigned nloc = b.st[0], nx = b.st[1];
        if (nloc == 0u) { xcd_barrier_complete(bar, b.x, nloc, nx); b.st[0] = nloc; b.st[1] = nx; }
        const unsigned old = xb_add(&bar[XB_XSUB(b.x)], 1u);
        const unsigned gen = old / nloc;
        if (old + 1u == (gen + 1u) * nloc) {
            __builtin_amdgcn_fence(__ATOMIC_RELEASE, "agent");
            asm volatile("s_waitcnt vmcnt(0)" ::: "memory");
            const unsigned og = xb_add(&bar[XB_TOP], 1u);
            if (og + 1u == (gen + 1u) * nx) {
#pragma unroll
                for (unsigned j = 0; j < 16; ++j) (void)__hip_atomic_fetch_add(&bar[XB_XGEN(j)], 1u, __ATOMIC_RELAXED, __HIP_MEMORY_SCOPE_AGENT);
            }
        }
        XB_SPIN(xb_ld(&bar[XB_XGEN(b.x)]) == gen, bar);
        __builtin_amdgcn_fence(__ATOMIC_ACQUIRE, "agent");
        asm volatile("s_waitcnt vmcnt(0)" ::: "memory");
    }
    __syncthreads();
}

constexpr int NWAVES = 8, NTHR = 512;
struct Args { const float* in[29]; float* out; unsigned char* ws; int ph_lo, ph_hi; };
static_assert(sizeof(Args) == 31 * 8 + 8, "Args has no padding");
enum { I_X = 0, I_MEM, I_GMIX, I_WIN, I_CONVW, I_CONVB, I_WA, I_BA, I_WX, I_BX, I_LAM, I_QN, I_KN, I_SINK, I_GMEM, I_WMKV, I_QNM, I_KNM, I_GOL, I_GOS, I_GOM, I_WOUT, I_GFFN, I_WR, I_BR, I_W1, I_B1, I_W2, I_B2 };

struct Frame {
    LAS unsigned char* lds;
    int tid, lane, wave, G, bid;
    float* out; unsigned char* ws;
};
struct InTab { const LAS unsigned* t;
    __device__ __forceinline__ const float* operator[](int i) const { const unsigned lo = __builtin_amdgcn_readfirstlane(t[2 * i]), hi = __builtin_amdgcn_readfirstlane(t[2 * i + 1]); return (const float*)(const GAS float*)(((unsigned long long)hi << 32) | lo); } };
__device__ __forceinline__ float wave_sum(float v) {
#pragma unroll
    for (int o = 1; o < 64; o <<= 1) v += __shfl_xor(v, o);
    return v;
}

template <int MODE>
__device__ __forceinline__ void p0_transpose_item(const float* W, int N, int Kp, const float* kscale, bf16* WT, LAS float* scr, int kb, int nb, int lane) {
    const int k0 = 64 * kb, n0 = 32 * nb;
    float v[32];
#pragma unroll
    for (int i = 0; i < 32; ++i) { const int kk = 2 * i + (lane >> 5); v[i] = W[(size_t)(k0 + kk) * N + n0 + (lane & 31)]; }
#pragma unroll
    for (int i = 0; i < 32; ++i) { const int kk = 2 * i + (lane >> 5); scr[kk * 33 + (lane & 31)] = kscale ? v[i] * kscale[k0 + kk] : v[i]; }
    LDS_WAIT(); asm volatile("" ::: "memory");
    const int c = lane & 7;
#pragma unroll
    for (int j = 0; j < 4; ++j) { const int n = (lane >> 3) + 8 * j; const LAS float* s = scr + (8 * c) * 33 + n;
        u32x4 o; o.x = pk2(s[0 * 33], s[1 * 33]); o.y = pk2(s[2 * 33], s[3 * 33]); o.z = pk2(s[4 * 33], s[5 * 33]); o.w = pk2(s[6 * 33], s[7 * 33]);
        int nn = n0 + n; if (MODE == 1) { const int a = nn >> 1, s1 = nn & 1; nn = 256 * (a >> 7) + 128 * s1 + (a & 127); }
        *(GAS u32x4*)(WT + (size_t)nn * Kp + k0 + 8 * c) = o; }
    LDS_WAIT(); asm volatile("" ::: "memory");
}
__device__ __forceinline__ void p0_prologue(Frame& F) {
    const InTab in{(const LAS unsigned*)(F.lds + PTAB_OFF)}; unsigned char* ws = F.ws;
    {
        LAS float* XN = (LAS float*)F.lds;
        LAS float* PART = (LAS float*)(F.lds + 32768);
        bf16* KM = (bf16*)(ws + SM_KM); bf16* VM = (bf16*)(ws + SM_VM); bf16* VMT = (bf16*)(ws + SM_VMT);
        for (int unit = F.bid; unit < 256; unit += F.G) {
            const int rg = unit >> 3, cs = unit & 7;
            __syncthreads();
            { const int m = 8 * rg + F.wave; const GAS f32x4* mr = (const GAS f32x4*)(in[I_MEM] + (size_t)m * D) + F.lane; f32x4 v[4]; float sq = 0.f;
#pragma unroll
              for (int j = 0; j < 4; ++j) { v[j] = mr[64 * j]; sq += (v[j].x * v[j].x + v[j].y * v[j].y) + (v[j].z * v[j].z + v[j].w * v[j].w); }
              const float rs = 1.0f / sqrtf(wave_sum(sq) * (1.0f / D) + EPS);
#pragma unroll
              for (int j = 0; j < 4; ++j) { const f32x4 g = *(const f32x4*)(in[I_GMEM] + 256 * j + 4 * F.lane); *(LAS f32x4*)(XN + F.wave * 1024 + 256 * j + 4 * F.lane) = v[j] * rs * g; } }
            __syncthreads();
            const int col = F.lane, kg = F.wave;
            float a[8];
#pragma unroll
            for (int r = 0; r < 8; ++r) a[r] = 0.f;
            const float* wp = in[I_WMKV] + (size_t)(128 * kg) * 512 + 64 * cs + col;
#pragma unroll 4
            for (int k = 0; k < 128; k += 4) {
                const float w0 = wp[(size_t)k * 512], w1 = wp[(size_t)(k + 1) * 512], w2 = wp[(size_t)(k + 2) * 512], w3 = wp[(size_t)(k + 3) * 512];
#pragma unroll
                for (int r = 0; r < 8; ++r) { const f32x4 x = *(const LAS f32x4*)(XN + r * 1024 + 128 * kg + k); a[r] += x.x * w0 + x.y * w1 + x.z * w2 + x.w * w3; }
            }
#pragma unroll
            for (int r = 0; r < 8; ++r) PART[(kg * 8 + r) * 64 + col] = a[r];
            __syncthreads();
            { const int r = F.wave, m = 8 * rg + r; float v = 0.f;
#pragma unroll
              for (int g = 0; g < 8; ++g) v += PART[(g * 8 + r) * 64 + col];
              if (cs < 4) { const float rk = 1.0f / sqrtf(wave_sum(v * v) * (1.0f / 64.0f) + EPS); KM[((size_t)cs * MEM_LEN + m) * 64 + col] = (bf16)f2bf(v * rk * in[I_KNM][col]); }
              else { const int h = cs - 4; VM[((size_t)h * MEM_LEN + m) * 64 + col] = (bf16)f2bf(v); const int kk = m & 31; VMT[((size_t)h * 64 + col) * MEM_LEN + (m & ~31) + 8 * ((kk >> 2) & 3) + 4 * (kk >> 4) + (kk & 3)] = (bf16)f2bf(v); } }
        }
        __syncthreads();
    }
    LAS float* scr = (LAS float*)(F.lds + F.wave * 16384);
    const int gw = F.bid * NWAVES + F.wave, NGW = F.G * NWAVES;
    constexpr int I_IN = 16 * 52, I_OUT = 16 * 32, I_W1E = 8 * 64, I_W2E = 8 * 32, I_LRU = 24;
    constexpr int NITEMS = I_IN + I_OUT + 32 * I_W1E + 32 * I_W2E + I_LRU;
    for (int it = gw; it < NITEMS - 32 * I_W1E - 32 * I_W2E; it += NGW) {
        int r = it;
        if (r < I_IN) { p0_transpose_item<0>(in[I_WIN], D_IN, D, in[I_GMIX], (bf16*)(ws + WS_WIN), scr, r / 52, r % 52, F.lane); continue; } r -= I_IN;
        if (r < I_OUT) { p0_transpose_item<0>(in[I_WOUT], D, D, nullptr, (bf16*)(ws + WS_WOUT), scr, r / 32, r % 32, F.lane); continue; } r -= I_OUT;
        { const int mat = r / 12, q = r % 12, h = q / 2, nb = q % 2;
          p0_transpose_item<0>(in[mat ? I_WX : I_WA] + (size_t)h * 4096, 64, 64, nullptr, (bf16*)(ws + (mat ? SM_WXT : SM_WAT)) + (size_t)h * 4096, scr, 0, nb, F.lane); }
    }
    const int gt = F.bid * NTHR + F.tid, NGT = F.G * NTHR;
    { u32x4* z = (u32x4*)((bf16*)(ws + WS_WIN) + (size_t)D_IN * D); for (int i = gt; i < (D_INP - D_IN) * D * 2 / 16; i += NGT) z[i] = (u32x4){0u, 0u, 0u, 0u}; }
    { float* b1p = (float*)(ws + SM_B1P); for (int i = gt; i < NE * FF2; i += NGT) { const int e = i / FF2, np = i % FF2; const int pn = np >> 8, s1 = (np >> 7) & 1, xx = np & 127; b1p[i] = in[I_B1][(size_t)e * FF2 + 2 * (128 * pn + xx) + s1]; } }
    { bf16* wrh = (bf16*)(ws + SM_WRH); bf16* wrl = (bf16*)(ws + SM_WRL);
      for (int i = gt; i < NE * D; i += NGT) { const int e = i >> 10, k = i & 1023; const float w = in[I_WR][(size_t)k * NE + e] * in[I_GFFN][k]; const unsigned hi = f2bf(w); wrh[i] = (bf16)hi; wrl[i] = (bf16)f2bf(w - __uint_as_float(hi << 16)); } }
    for (int m = 2 * gw; m < S; m += 2 * NGW) {
        const GAS f32x4* xr = (const GAS f32x4*)(in[I_X] + (size_t)m * D) + F.lane;
        f32x4 v[8]; float s2 = 0.f, s3 = 0.f;
#pragma unroll
        for (int j = 0; j < 8; ++j) v[j] = __builtin_nontemporal_load(xr + 64 * j);
#pragma unroll
        for (int j = 0; j < 4; ++j) { s2 += (v[j].x * v[j].x + v[j].y * v[j].y) + (v[j].z * v[j].z + v[j].w * v[j].w); s3 += (v[4 + j].x * v[4 + j].x + v[4 + j].y * v[4 + j].y) + (v[4 + j].z * v[4 + j].z + v[4 + j].w * v[4 + j].w); }
        s2 = wave_sum(s2); s3 = wave_sum(s3);
        if (F.lane == 0) { ((float*)(ws + SM_RSTD1))[m] = 1.0f / sqrtf(s2 * (1.0f / D) + EPS); ((float*)(ws + SM_RSTD1))[m + 1] = 1.0f / sqrtf(s3 * (1.0f / D) + EPS); }
        GAS unsigned long long* o8 = (GAS unsigned long long*)((bf16*)(ws + WS_XB) + (size_t)m * D) + F.lane;
#pragma unroll
        for (int j = 0; j < 8; ++j) o8[64 * j] = (unsigned long long)pk2(v[j].x, v[j].y) | ((unsigned long long)pk2(v[j].z, v[j].w) << 32);
    }
}

__device__ __forceinline__ float sigmoidf_(float x) { return __builtin_amdgcn_rcpf(1.0f + __builtin_amdgcn_exp2f(-1.4426950408889634f * x)); }
__device__ __forceinline__ float gelu_tanh(float x) { const float u = 0.7978845608028654f * (x + 0.044715f * x * x * x); return x * sigmoidf_(2.0f * u); }
__device__ __forceinline__ float rsq_(float x) { return __builtin_amdgcn_rsqf(x); }
__device__ __forceinline__ float sqrt_negexpm1(float x) { const float ser = -x * (1.0f + x * (0.5f + x * (0.16666667f + x * 0.041666668f))); const float dir = 1.0f - __builtin_amdgcn_exp2f(1.4426950408889634f * x);
    return __builtin_amdgcn_sqrtf(fmaxf(x > -0.125f ? ser : dir, 0.f)); }

__device__ __forceinline__ f32x4 mfma16(bf16x8 a, bf16x8 b, f32x4 c) { return __builtin_amdgcn_mfma_f32_16x16x32_bf16(a, b, c, 0, 0, 0); }
__device__ __forceinline__ bf16x8 frag_from(u32x4 w) { return __builtin_bit_cast(bf16x8, w); }
constexpr float LOG2E = 1.4426950408889634f;
__device__ __forceinline__ void q_frags(const bf16* U, int t, int col0, const float* gain, int g, bf16x8& q0, bf16x8& q1) {
    const bf16* qp = U + (size_t)t * D_INP + col0 + 8 * g;
    const u32x4 w0 = *(const u32x4*)qp, w1 = *(const u32x4*)(qp + 32);
    float f[16] = {bflo(w0.x), bfhi(w0.x), bflo(w0.y), bfhi(w0.y), bflo(w0.z), bfhi(w0.z), bflo(w0.w), bfhi(w0.w), bflo(w1.x), bfhi(w1.x), bflo(w1.y), bfhi(w1.y), bflo(w1.z), bfhi(w1.z), bflo(w1.w), bfhi(w1.w)};
    float sq = 0.f;
#pragma unroll
    for (int j = 0; j < 16; ++j) sq += f[j] * f[j];
    sq += __shfl_xor(sq, 16); sq += __shfl_xor(sq, 32);
    const float rs = 0.125f * LOG2E * rsq_(sq * (1.0f / 64.0f) + EPS);
    const f32x4 ga = *(const f32x4*)(gain + 8 * g), gb = *(const f32x4*)(gain + 8 * g + 4), gc = *(const f32x4*)(gain + 32 + 8 * g), gd = *(const f32x4*)(gain + 32 + 8 * g + 4);
    u32x4 o0, o1;
    o0.x = pk2(f[0] * rs * ga.x, f[1] * rs * ga.y); o0.y = pk2(f[2] * rs * ga.z, f[3] * rs * ga.w); o0.z = pk2(f[4] * rs * gb.x, f[5] * rs * gb.y); o0.w = pk2(f[6] * rs * gb.z, f[7] * rs * gb.w);
    o1.x = pk2(f[8] * rs * gc.x, f[9] * rs * gc.y); o1.y = pk2(f[10] * rs * gc.z, f[11] * rs * gc.w); o1.z = pk2(f[12] * rs * gd.x, f[13] * rs * gd.y); o1.w = pk2(f[14] * rs * gd.z, f[15] * rs * gd.w);
    q0 = frag_from(o0); q1 = frag_from(o1);
}

__device__ __forceinline__ void swa_tile_mfma(Frame& F, int b, pg8::W1Rider& R) {
    const InTab in{(const LAS unsigned*)(F.lds + PTAB_OFF)}; unsigned char* ws = F.ws;
    const bf16* U = (const bf16*)(ws + WS_U);
    constexpr int KP = 72, VP = 216;
    LAS bf16* Ks = (LAS bf16*)F.lds;
    LAS bf16* VT = Ks + 2 * 192 * KP;
    LAS float* SSQ = (LAS float*)(F.lds + 110592);
    const int t0 = 64 * b, g = F.lane >> 4, c16 = F.lane & 15;
    R.issue(F.lane);
    bf16x8 qf[3][2];
#pragma unroll
    for (int pi = 0; pi < 3; ++pi) { const int p = (F.tid >> 6) + 8 * pi, head = p >> 2, qt = p & 3; q_frags(U, t0 + 16 * qt + c16, OFF_Q + head * 64, in[I_QN], g, qf[pi][0], qf[pi][1]); }
    __syncthreads();
    for (int it = F.tid; it < 2 * 192 * 8; it += NTHR) {
        const int dg = it & 7, key = (it >> 3) % 192, kvh = it / 1536; const int pos = t0 - 128 + key;
        u32x4 kv = (u32x4){0u, 0u, 0u, 0u}, vv = kv;
        if (pos >= 0) { kv = *(const u32x4*)(U + (size_t)pos * D_INP + OFF_K + kvh * 64 + dg * 8); vv = *(const u32x4*)(U + (size_t)pos * D_INP + OFF_V + kvh * 64 + dg * 8); }
        float f[8] = {bflo(kv.x), bfhi(kv.x), bflo(kv.y), bfhi(kv.y), bflo(kv.z), bfhi(kv.z), bflo(kv.w), bfhi(kv.w)};
        float sq = 0.f;
#pragma unroll
        for (int j = 0; j < 8; ++j) sq += f[j] * f[j];
        sq += __shfl_xor(sq, 1); sq += __shfl_xor(sq, 2); sq += __shfl_xor(sq, 4);
        const float rs = rsq_(sq * (1.0f / 64.0f) + EPS); const float* kn = in[I_KN] + dg * 8;
        u32x4 o; o.x = pk2(f[0] * rs * kn[0], f[1] * rs * kn[1]); o.y = pk2(f[2] * rs * kn[2], f[3] * rs * kn[3]); o.z = pk2(f[4] * rs * kn[4], f[5] * rs * kn[5]); o.w = pk2(f[6] * rs * kn[6], f[7] * rs * kn[7]);
        *(LAS u32x4*)(Ks + (kvh * 192 + key) * KP + dg * 8) = o;
        LAS bf16* vt = VT + (kvh * 64 + dg * 8) * VP + key;
        vt[0 * VP] = (bf16)(vv.x & 0xffffu); vt[1 * VP] = (bf16)(vv.x >> 16); vt[2 * VP] = (bf16)(vv.y & 0xffffu); vt[3 * VP] = (bf16)(vv.y >> 16);
        vt[4 * VP] = (bf16)(vv.z & 0xffffu); vt[5 * VP] = (bf16)(vv.z >> 16); vt[6 * VP] = (bf16)(vv.w & 0xffffu); vt[7 * VP] = (bf16)(vv.w >> 16);
    }
    for (int it = F.tid; it < 2 * 64 * 24; it += NTHR) VT[(it / 24) * VP + 192 + (it % 24)] = (bf16)0;
    R.retire(F.lane);
    __syncthreads();
    f32x4 oacc[3][4];
#pragma unroll
    for (int pi = 0; pi < 3; ++pi) {
        const int p = (F.tid >> 6) + 8 * pi, head = p >> 2, qt = p & 3, kvh = head / 3;
        const bf16x8 q0 = qf[pi][0], q1 = qf[pi][1];
        f32x4 st[10];
#pragma unroll
        for (int i = 0; i < 9; ++i) { const LAS bf16* kr = Ks + (kvh * 192 + 16 * (qt + i) + c16) * KP + 8 * g;
            f32x4 a = (f32x4){0.f, 0.f, 0.f, 0.f}; a = mfma16(*(const LAS bf16x8*)kr, q0, a); a = mfma16(*(const LAS bf16x8*)(kr + 32), q1, a); st[i] = a; }
        const float sink = in[I_SINK][head] * LOG2E; float mx = sink;
#pragma unroll
        for (int i = 0; i < 9; ++i)
#pragma unroll
            for (int r = 0; r < 4; ++r) { const int koff = 4 * g + r; bool ok = (t0 - 128 + 16 * (qt + i) + koff) >= 0; if (i == 0) ok = ok && (koff > c16); if (i == 8) ok = ok && (koff <= c16);
                st[i][r] = ok ? st[i][r] : -1.0e30f; mx = fmaxf(mx, st[i][r]); }
        mx = fmaxf(mx, __shfl_xor(mx, 16)); mx = fmaxf(mx, __shfl_xor(mx, 32));
        float l = 0.f;
#pragma unroll
        for (int i = 0; i < 9; ++i)
#pragma unroll
            for (int r = 0; r < 4; ++r) { st[i][r] = __builtin_amdgcn_exp2f(st[i][r] - mx); l += st[i][r]; }
        st[9] = (f32x4){0.f, 0.f, 0.f, 0.f};
        l += __shfl_xor(l, 16); l += __shfl_xor(l, 32); l += __builtin_amdgcn_exp2f(sink - mx);
        f32x4 ot[4];
#pragma unroll
        for (int dt = 0; dt < 4; ++dt) ot[dt] = (f32x4){0.f, 0.f, 0.f, 0.f};
#pragma unroll
        for (int u = 0; u < 5; ++u) {
            u32x4 pw; pw.x = pk2(st[2 * u][0], st[2 * u][1]); pw.y = pk2(st[2 * u][2], st[2 * u][3]); pw.z = pk2(st[2 * u + 1][0], st[2 * u + 1][1]); pw.w = pk2(st[2 * u + 1][2], st[2 * u + 1][3]);
            const bf16x8 pf = frag_from(pw);
#pragma unroll
            for (int dt = 0; dt < 4; ++dt) { const LAS bf16* vr = VT + (kvh * 64 + 16 * dt + c16) * VP + 16 * (qt + 2 * u) + 4 * g;
                const u32x2 lo = *(const LAS u32x2*)vr, hi = *(const LAS u32x2*)(vr + 16);
                ot[dt] = mfma16(frag_from((u32x4){lo.x, lo.y, hi.x, hi.y}), pf, ot[dt]); }
        }
        const float il = __builtin_amdgcn_rcpf(l); float sq = 0.f;
#pragma unroll
        for (int dt = 0; dt < 4; ++dt) { oacc[pi][dt] = ot[dt] * il; sq += (oacc[pi][dt][0] * oacc[pi][dt][0] + oacc[pi][dt][1] * oacc[pi][dt][1]) + (oacc[pi][dt][2] * oacc[pi][dt][2] + oacc[pi][dt][3] * oacc[pi][dt][3]); }
        sq += __shfl_xor(sq, 16); sq += __shfl_xor(sq, 32);
        if (g == 0) SSQ[head * 64 + 16 * qt + c16] = sq;
    }
    R.issue(F.lane);
    __syncthreads();
#pragma unroll
    for (int pi = 0; pi < 3; ++pi) {
        const int p = (F.tid >> 6) + 8 * pi, head = p >> 2, qt = p & 3; const int ql = 16 * qt + c16;
        const float tot = (SSQ[ql] + SSQ[64 + ql]) + (SSQ[128 + ql] + SSQ[192 + ql]) + (SSQ[256 + ql] + SSQ[320 + ql]);
        const float rs = rsq_(tot * (1.0f / 384.0f) + EPS);
        bf16* yo = (bf16*)(ws + WS_Y) + (size_t)(t0 + ql) * D + 384 + head * 64 + 4 * g; const float* gp = in[I_GOS] + head * 64 + 4 * g;
#pragma unroll
        for (int dt = 0; dt < 4; ++dt) { const f32x4 gv = *(const f32x4*)(gp + 16 * dt); const f32x4 o = oacc[pi][dt] * rs * gv; u32x2 w; w.x = pk2(o[0], o[1]); w.y = pk2(o[2], o[3]); *(u32x2*)(yo + 16 * dt) = w; }
    }
    R.retire(F.lane);
    __syncthreads();
}

__device__ __forceinline__ void mem_tile_mfma(Frame& F, int b, pg8::W1Rider& R) {
    const InTab in{(const LAS unsigned*)(F.lds + PTAB_OFF)}; unsigned char* ws = F.ws;
    const bf16* U = (const bf16*)(ws + WS_U);
    LAS unsigned char* KV = F.lds;
    LAS float* SSQ = (LAS float*)(F.lds + RING_BYTES + 5120);
    const int t0 = 64 * b, g = F.lane >> 4, c16 = F.lane & 15, head = F.tid >> 7, wq = (F.tid >> 6) & 1;
    R.issue(F.lane);
    bf16x8 q[2][2];
#pragma unroll
    for (int qi = 0; qi < 2; ++qi) q_frags(U, t0 + 16 * (2 * wq + qi) + c16, OFF_QM + head * 64, in[I_QNM], g, q[qi][0], q[qi][1]);
    __syncthreads();
    { const u32x4* src = (const u32x4*)(ws + SM_KM);
#pragma unroll 8
      for (int j = 0; j < 16; ++j) { const int idx = F.tid + 512 * j, c = idx & 7, row = idx >> 3; *(LAS u32x4*)(KV + (row * 8 + (c ^ (row & 7))) * 16) = src[idx]; } }
    R.retire(F.lane);
    __syncthreads();
    f32x4 st[2][16];
#pragma unroll
    for (int kt = 0; kt < 16; ++kt) { const int row = head * 256 + 16 * kt + c16;
        const bf16x8 k0 = *(const LAS bf16x8*)(KV + (row * 8 + (g ^ (row & 7))) * 16), k1 = *(const LAS bf16x8*)(KV + (row * 8 + ((4 + g) ^ (row & 7))) * 16);
#pragma unroll
        for (int qi = 0; qi < 2; ++qi) { f32x4 a = (f32x4){0.f, 0.f, 0.f, 0.f}; a = mfma16(k0, q[qi][0], a); a = mfma16(k1, q[qi][1], a); st[qi][kt] = a; } }
    u32x4 pf[2][8]; float il[2];
#pragma unroll
    for (int qi = 0; qi < 2; ++qi) { float mx = -1.0e30f;
#pragma unroll
        for (int kt = 0; kt < 16; ++kt) mx = fmaxf(fmaxf(mx, fmaxf(st[qi][kt][0], st[qi][kt][1])), fmaxf(st[qi][kt][2], st[qi][kt][3]));
        mx = fmaxf(mx, __shfl_xor(mx, 16)); mx = fmaxf(mx, __shfl_xor(mx, 32));
        float l = 0.f;
#pragma unroll
        for (int kt = 0; kt < 16; ++kt)
#pragma unroll
            for (int r = 0; r < 4; ++r) { st[qi][kt][r] = __builtin_amdgcn_exp2f(st[qi][kt][r] - mx); l += st[qi][kt][r]; }
        l += __shfl_xor(l, 16); l += __shfl_xor(l, 32); il[qi] = __builtin_amdgcn_rcpf(l);
#pragma unroll
        for (int u = 0; u < 8; ++u) { pf[qi][u].x = pk2(st[qi][2 * u][0], st[qi][2 * u][1]); pf[qi][u].y = pk2(st[qi][2 * u][2], st[qi][2 * u][3]); pf[qi][u].z = pk2(st[qi][2 * u + 1][0], st[qi][2 * u + 1][1]); pf[qi][u].w = pk2(st[qi][2 * u + 1][2], st[qi][2 * u + 1][3]); } }
    R.issue(F.lane);
    __syncthreads();
    { const u32x4* src = (const u32x4*)(ws + SM_VMT);
#pragma unroll 8
      for (int j = 0; j < 16; ++j) { const int idx = F.tid + 512 * j, c = idx & 31, row = idx >> 5; *(LAS u32x4*)(KV + (row * 32 + (c ^ (row & 7))) * 16) = src[idx]; } }
    R.retire(F.lane);
    __syncthreads();
    f32x4 ot[2][4];
#pragma unroll
    for (int qi = 0; qi < 2; ++qi)
#pragma unroll
        for (int dt = 0; dt < 4; ++dt) ot[qi][dt] = (f32x4){0.f, 0.f, 0.f, 0.f};
#pragma unroll
    for (int u = 0; u < 8; ++u)
#pragma unroll
        for (int dt = 0; dt < 4; ++dt) { const int row = head * 64 + 16 * dt + c16; const bf16x8 vf = *(const LAS bf16x8*)(KV + (row * 32 + ((4 * u + g) ^ (row & 7))) * 16);
            ot[0][dt] = mfma16(vf, frag_from(pf[0][u]), ot[0][dt]); ot[1][dt] = mfma16(vf, frag_from(pf[1][u]), ot[1][dt]); }
#pragma unroll
    for (int qi = 0; qi < 2; ++qi) { float sq = 0.f;
#pragma unroll
        for (int dt = 0; dt < 4; ++dt) { ot[qi][dt] *= il[qi]; sq += (ot[qi][dt][0] * ot[qi][dt][0] + ot[qi][dt][1] * ot[qi][dt][1]) + (ot[qi][dt][2] * ot[qi][dt][2] + ot[qi][dt][3] * ot[qi][dt][3]); }
        sq += __shfl_xor(sq, 16); sq += __shfl_xor(sq, 32);
        if (g == 0) SSQ[head * 64 + 16 * (2 * wq + qi) + c16] = sq; }
    R.issue(F.lane);
    __syncthreads();
#pragma unroll
    for (int qi = 0; qi < 2; ++qi) {
        const int ql = 16 * (2 * wq + qi) + c16;
        const float tot = (SSQ[ql] + SSQ[64 + ql]) + (SSQ[128 + ql] + SSQ[192 + ql]);
        const float rs = rsq_(tot * (1.0f / 256.0f) + EPS);
        bf16* yo = (bf16*)(ws + WS_Y) + (size_t)(t0 + ql) * D + 768 + head * 64 + 4 * g; const float* gp = in[I_GOM] + head * 64 + 4 * g;
#pragma unroll
        for (int dt = 0; dt < 4; ++dt) { const f32x4 gv = *(const f32x4*)(gp + 16 * dt); const f32x4 o = ot[qi][dt] * rs * gv; u32x2 w; w.x = pk2(o[0], o[1]); w.y = pk2(o[2], o[3]); *(u32x2*)(yo + 16 * dt) = w; }
    }
    R.retire(F.lane);
    __syncthreads();
}

__device__ __forceinline__ void lru_tile_mfma(Frame& F, int b, pg8::W1Rider& R) {
    const InTab in{(const LAS unsigned*)(F.lds + PTAB_OFF)}; unsigned char* ws = F.ws;
    const bf16* U = (const bf16*)(ws + WS_U);
    constexpr int UP = 72;
    LAS bf16* UL = (LAS bf16*)(F.lds + (F.tid >> 6) * 20480);
    LAS bf16* GL = UL + 68 * UP;
    float* AAGG = (float*)(ws + SM_AAGG); float* BAGG = (float*)(ws + SM_BAGG); unsigned* YP = (unsigned*)(ws + WS_YP);
    const int t0 = 64 * b, g = F.lane >> 4, c16 = F.lane & 15, hd = F.tid >> 6;
    __syncthreads();
    if (hd < 6) {
        for (int idx = F.lane; idx < 67 * 8; idx += 64) { const int row = idx >> 3, ch = idx & 7, t = t0 - 3 + row;
            u32x4 v = (u32x4){0u, 0u, 0u, 0u}; if (t >= 0) v = *(const u32x4*)(U + (size_t)t * D_INP + OFF_LRU + hd * 64 + 8 * ch);
            *(LAS u32x4*)(UL + row * UP + 8 * ch) = v; }
        for (int idx = F.lane; idx < 64 * 8; idx += 64) { const int row = idx >> 3, ch = idx & 7;
            *(LAS u32x4*)(GL + row * UP + 8 * ch) = *(const u32x4*)(U + (size_t)(t0 + row) * D_INP + OFF_GATE + hd * 64 + 8 * ch); }
        LDS_WAIT(); asm volatile("" ::: "memory");
        bf16x8 xa[4][2];
#pragma unroll
        for (int s = 0; s < 2; ++s) {
            const int cbase = hd * 64 + 32 * s + 8 * g;
            float cw[4][8], cbv[8];
#pragma unroll
            for (int k = 0; k < 4; ++k) { const f32x4 a = *(const f32x4*)(in[I_CONVW] + k * 384 + cbase), bq = *(const f32x4*)(in[I_CONVW] + k * 384 + cbase + 4);
                cw[k][0] = a.x; cw[k][1] = a.y; cw[k][2] = a.z; cw[k][3] = a.w; cw[k][4] = bq.x; cw[k][5] = bq.y; cw[k][6] = bq.z; cw[k][7] = bq.w; }
            { const f32x4 a = *(const f32x4*)(in[I_CONVB] + cbase), bq = *(const f32x4*)(in[I_CONVB] + cbase + 4); cbv[0] = a.x; cbv[1] = a.y; cbv[2] = a.z; cbv[3] = a.w; cbv[4] = bq.x; cbv[5] = bq.y; cbv[6] = bq.z; cbv[7] = bq.w; }
#pragma unroll
            for (int tt = 0; tt < 4; ++tt) {
                float xv[8];
#pragma unroll
                for (int j = 0; j < 8; ++j) xv[j] = cbv[j];
#pragma unroll
                for (int k = 0; k < 4; ++k) { const u32x4 w = *(const LAS u32x4*)(UL + (16 * tt + c16 + k) * UP + 32 * s + 8 * g);
                    xv[0] += cw[k][0] * bflo(w.x); xv[1] += cw[k][1] * bfhi(w.x); xv[2] += cw[k][2] * bflo(w.y); xv[3] += cw[k][3] * bfhi(w.y);
                    xv[4] += cw[k][4] * bflo(w.z); xv[5] += cw[k][5] * bfhi(w.z); xv[6] += cw[k][6] * bflo(w.w); xv[7] += cw[k][7] * bfhi(w.w); }
                xa[tt][s] = frag_from((u32x4){pk2(xv[0], xv[1]), pk2(xv[2], xv[3]), pk2(xv[4], xv[5]), pk2(xv[6], xv[7])});
            }
        }
        const bf16* WaT = (const bf16*)(ws + SM_WAT) + (size_t)hd * 4096; const bf16* WxT = (const bf16*)(ws + SM_WXT) + (size_t)hd * 4096;
        bf16x8 wan[2], wxn[2];
#pragma unroll
        for (int s = 0; s < 2; ++s) { wan[s] = *(const bf16x8*)(WaT + c16 * 64 + 32 * s + 8 * g); wxn[s] = *(const bf16x8*)(WxT + c16 * 64 + 32 * s + 8 * g); }
#pragma unroll 1
        for (int ct = 0; ct < 4; ++ct) {
            const int cp = 16 * ct + c16, c = hd * 64 + cp;
            bf16x8 waf[2], wxf[2], idf[2];
#pragma unroll
            for (int s = 0; s < 2; ++s) { waf[s] = wan[s]; wxf[s] = wxn[s]; const int cpn = 16 * ((ct + 1) & 3) + c16; wan[s] = *(const bf16x8*)(WaT + cpn * 64 + 32 * s + 8 * g); wxn[s] = *(const bf16x8*)(WxT + cpn * 64 + 32 * s + 8 * g);
                u32x4 iw; const int kb = 32 * s + 8 * g;
                iw.x = (kb + 0 == cp ? 0x3F80u : 0u) | (kb + 1 == cp ? 0x3F800000u : 0u); iw.y = (kb + 2 == cp ? 0x3F80u : 0u) | (kb + 3 == cp ? 0x3F800000u : 0u);
                iw.z = (kb + 4 == cp ? 0x3F80u : 0u) | (kb + 5 == cp ? 0x3F800000u : 0u); iw.w = (kb + 6 == cp ? 0x3F80u : 0u) | (kb + 7 == cp ? 0x3F800000u : 0u); idf[s] = frag_from(iw); }
            f32x4 Da[4], Dx[4], Dc[4], yv[4];
#pragma unroll
            for (int tt = 0; tt < 4; ++tt) { f32x4 z = (f32x4){0.f, 0.f, 0.f, 0.f};
                Da[tt] = mfma16(xa[tt][1], waf[1], mfma16(xa[tt][0], waf[0], z)); Dx[tt] = mfma16(xa[tt][1], wxf[1], mfma16(xa[tt][0], wxf[0], z)); Dc[tt] = mfma16(xa[tt][1], idf[1], mfma16(xa[tt][0], idf[0], z));
                const f32x4 dg = mfma16(*(const LAS bf16x8*)(GL + (16 * tt + c16) * UP + 32 + 8 * g), idf[1], mfma16(*(const LAS bf16x8*)(GL + (16 * tt + c16) * UP + 8 * g), idf[0], z));
#pragma unroll
                for (int r = 0; r < 4; ++r) yv[tt][r] = gelu_tanh(dg[r]); }
            const float sp = log1pf(__expf(-in[I_LAM][c])), ba = in[I_BA][c], bxb = in[I_BX][c];
#pragma unroll
            for (int tt = 0; tt < 4; ++tt)
#pragma unroll
                for (int r = 0; r < 4; ++r) { const float rr = sigmoidf_(Da[tt][r] + ba), ig = sigmoidf_(Dx[tt][r] + bxb); const float la = -8.0f * rr * sp;
                    Da[tt][r] = __builtin_amdgcn_exp2f(LOG2E * la); Dx[tt][r] = sqrt_negexpm1(2.0f * la) * ig * Dc[tt][r]; }
            float hs = 0.f, Atot = 1.f;
#pragma unroll
            for (int tt = 0; tt < 4; ++tt) {
                const f32x4 a = Da[tt], bb = Dx[tt];
                float Ai = (a[0] * a[1]) * (a[2] * a[3]), Bi = ((bb[0] * a[1] + bb[1]) * a[2] + bb[2]) * a[3] + bb[3];
                float Ap = __shfl_up(Ai, 16), Bp = __shfl_up(Bi, 16); if (g >= 1) { Bi = Ai * Bp + Bi; Ai = Ap * Ai; }
                Ap = __shfl_up(Ai, 32); Bp = __shfl_up(Bi, 32); if (g >= 2) { Bi = Ai * Bp + Bi; Ai = Ap * Ai; }
                float Ae = __shfl_up(Ai, 16), Be = __shfl_up(Bi, 16); if (g == 0) { Ae = 1.f; Be = 0.f; }
                float hl = Ae * hs + Be, pl = Atot * Ae;
#pragma unroll
                for (int r = 0; r < 4; ++r) { hl = a[r] * hl + bb[r]; pl *= a[r];
                    YP[(size_t)(t0 + 16 * tt + 4 * g + r) * 384 + c] = pk2(hl * yv[tt][r], pl * yv[tt][r]); }
                const float A3 = __shfl(Ai, c16 + 48), B3 = __shfl(Bi, c16 + 48); hs = A3 * hs + B3; Atot *= A3;
            }
            if (g == 0) { AAGG[(size_t)c * NTILE + b] = Atot; BAGG[(size_t)c * NTILE + b] = hs; }
            }
    }
    __syncthreads();
}

__device__ __forceinline__ void lru_fix_tile(Frame& F, int b, pg8::W1Rider& R) {
    const InTab in{(const LAS unsigned*)(F.lds + PTAB_OFF)}; unsigned char* ws = F.ws;
    LAS float* CR = (LAS float*)F.lds;
    const int t0 = 64 * b;
    R.issue(F.lane);
    __syncthreads();
    if (F.tid < 384) CR[F.tid] = ((const float*)(ws + SM_CARRY))[(size_t)F.tid * NTILE + b];
    __syncthreads();
    const int t = F.tid >> 3, part = F.tid & 7;
    const u32x4* yp = (const u32x4*)((const unsigned*)(ws + WS_YP) + (size_t)(t0 + t) * 384 + part * 48);
    float y[48]; float sq = 0.f;
#pragma unroll
    for (int j = 0; j < 12; ++j) { const u32x4 w = yp[j]; const f32x4 cr = *(const LAS f32x4*)(CR + part * 48 + 4 * j);
        y[4 * j] = bflo(w.x) + bfhi(w.x) * cr.x; y[4 * j + 1] = bflo(w.y) + bfhi(w.y) * cr.y; y[4 * j + 2] = bflo(w.z) + bfhi(w.z) * cr.z; y[4 * j + 3] = bflo(w.w) + bfhi(w.w) * cr.w;
        sq += (y[4 * j] * y[4 * j] + y[4 * j + 1] * y[4 * j + 1]) + (y[4 * j + 2] * y[4 * j + 2] + y[4 * j + 3] * y[4 * j + 3]); }
    sq += __shfl_xor(sq, 1); sq += __shfl_xor(sq, 2); sq += __shfl_xor(sq, 4);
    const float rs = rsq_(sq * (1.0f / 384.0f) + EPS);
    const float* gp = in[I_GOL] + part * 48; bf16* yo = (bf16*)(ws + WS_Y) + (size_t)(t0 + t) * D + part * 48;
#pragma unroll
    for (int j = 0; j < 6; ++j) { const f32x4 ga = *(const f32x4*)(gp + 8 * j), gb = *(const f32x4*)(gp + 8 * j + 4);
        u32x4 w; w.x = pk2(y[8 * j] * rs * ga.x, y[8 * j + 1] * rs * ga.y); w.y = pk2(y[8 * j + 2] * rs * ga.z, y[8 * j + 3] * rs * ga.w); w.z = pk2(y[8 * j + 4] * rs * gb.x, y[8 * j + 5] * rs * gb.y); w.w = pk2(y[8 * j + 6] * rs * gb.z, y[8 * j + 7] * rs * gb.w);
        *(u32x4*)(yo + 8 * j) = w; }
    R.retire(F.lane);
    __syncthreads();
}

__device__ __forceinline__ void moe_tables(Frame& F) {
    LAS int* cnt = (LAS int*)(F.lds + TAB_OFF); LAS int* tile_start = cnt + 32; LAS int* row_start = tile_start + 33; LAS int* mt_expert = row_start + 32;
    gu32* ctl = (gu32*)(F.ws + WS_CTL);
    __syncthreads();
    if (F.tid < 32) {
        const int e = F.tid, c = (int)__hip_atomic_load((unsigned*)(ctl + CW_CNT + 64 * e), RLX_AGENT), n = (c + 255) >> 8;
        int incl = n;
#pragma unroll
        for (int d = 1; d < 32; d <<= 1) { const int t = __shfl_up(incl, d); if (e >= d) incl += t; }
        const int ts = min(incl - n, MAXMT);
        cnt[e] = c; tile_start[e] = ts; row_start[e] = ts * 256;
        for (int j = 0; j < n && ts + j < MAXMT; ++j) mt_expert[ts + j] = e;
        if (e == 31) tile_start[32] = min(incl, MAXMT);
    }
    __syncthreads();
}


__device__ __forceinline__ void carry_scan(Frame& F) {
    unsigned char* ws = F.ws;
    const float* AAGG = (const float*)(ws + SM_AAGG); const float* BAGG = (const float*)(ws + SM_BAGG); float* CARRY = (float*)(ws + SM_CARRY);
    for (int c = F.wave * F.G + F.bid; c < 384; c += 8 * F.G) {
        const f32x4 a4 = *(const f32x4*)(AAGG + (size_t)c * NTILE + 4 * F.lane), b4 = *(const f32x4*)(BAGG + (size_t)c * NTILE + 4 * F.lane);
        float A = (a4[0] * a4[1]) * (a4[2] * a4[3]), B = ((b4[0] * a4[1] + b4[1]) * a4[2] + b4[2]) * a4[3] + b4[3];
#pragma unroll
        for (int d = 1; d < 64; d <<= 1) { const float Ap = __shfl_up(A, d), Bp = __shfl_up(B, d); if (F.lane >= d) { B = A * Bp + B; A = A * Ap; } }
        float h = __shfl_up(B, 1); if (F.lane == 0) h = 0.f;
        f32x4 o; o[0] = h; h = a4[0] * h + b4[0]; o[1] = h; h = a4[1] * h + b4[1]; o[2] = h; h = a4[2] * h + b4[2]; o[3] = h;
        *(f32x4*)(CARRY + (size_t)c * NTILE + 4 * F.lane) = o;
    }
}

__device__ __forceinline__ void router_tile_mfma(Frame& F, int b, pg8::W1Rider& R) {
    const InTab in{(const LAS unsigned*)(F.lds + PTAB_OFF)}; unsigned char* ws = F.ws;
    const bf16* H = (const bf16*)(ws + WS_HBF);
    LAS float* LOGP = (LAS float*)F.lds;
    LAS float* RS = (LAS float*)(F.lds + 2 * 64 * 33 * 4);
    LAS int* hist = (LAS int*)(RS + 64);
    LAS int* base = hist + 32;
    gu32* ctl = (gu32*)(ws + WS_CTL);
    const int t0 = 64 * b, g = F.lane >> 4, c16 = F.lane & 15, tt = F.wave & 3, kh = F.wave >> 2;
    __syncthreads();
    if (F.tid < 64) { const float* sp = (const float*)(ws + SM_SSQP) + (size_t)(t0 + F.tid) * 16; float s = 0.f;
#pragma unroll
        for (int j = 0; j < 4; ++j) { const f32x4 v = *(const f32x4*)(sp + 4 * j); s += (v.x + v.y) + (v.z + v.w); }
        const float r = rsq_(s * (1.0f / D) + EPS); RS[F.tid] = r; ((float*)(ws + SM_RSTD2))[t0 + F.tid] = r; }
    if (F.tid < 32) hist[F.tid] = 0;
    R.issue(F.lane);
    const f32x4 brv = *(const f32x4*)(in[I_BR] + 4 * (F.lane & 7));
    f32x4 acc0 = (f32x4){0.f, 0.f, 0.f, 0.f}, acc1 = acc0;
    const bf16* hp = H + (size_t)(t0 + 16 * tt + c16) * D + 512 * kh + 8 * g;
    const bf16* wh = (const bf16*)(ws + SM_WRH) + (size_t)c16 * D + 512 * kh + 8 * g; const bf16* wl = (const bf16*)(ws + SM_WRL) + (size_t)c16 * D + 512 * kh + 8 * g;
#pragma unroll 4
    for (int ks = 0; ks < 16; ++ks) {
        const bf16x8 ahi = *(const bf16x8*)(hp + 32 * ks);
        const bf16x8 wh0 = *(const bf16x8*)(wh + 32 * ks), wh1 = *(const bf16x8*)(wh + 16 * D + 32 * ks), wl0 = *(const bf16x8*)(wl + 32 * ks), wl1 = *(const bf16x8*)(wl + 16 * D + 32 * ks);
        acc0 = mfma16(ahi, wh0, acc0); acc0 = mfma16(ahi, wl0, acc0);
        acc1 = mfma16(ahi, wh1, acc1); acc1 = mfma16(ahi, wl1, acc1);
    }
    R.retire(F.lane);
#pragma unroll
    for (int r = 0; r < 4; ++r) { LOGP[(kh * 64 + 16 * tt + 4 * g + r) * 33 + c16] = acc0[r]; LOGP[(kh * 64 + 16 * tt + 4 * g + r) * 33 + 16 + c16] = acc1[r]; }
    __syncthreads();
    const int s8 = F.lane & 7, tk = 8 * F.wave + (F.lane >> 3);
    float v[4]; int es[4]; float vs[4];
    { const LAS float* l0 = LOGP + tk * 33 + 4 * s8; const LAS float* l1 = l0 + 64 * 33; const float rs = RS[tk];
#pragma unroll
        for (int i = 0; i < 4; ++i) v[i] = (l0[i] + l1[i]) * rs + brv[i]; }
#pragma unroll
    for (int k = 0; k < 4; ++k) {
        float bv = v[0]; int gi = 4 * s8;
#pragma unroll
        for (int i = 1; i < 4; ++i) if (v[i] > bv) { bv = v[i]; gi = 4 * s8 + i; }
#pragma unroll
        for (int d = 1; d < 8; d <<= 1) { const float ov = __shfl_xor(bv, d); const int oi = __shfl_xor(gi, d); if (ov > bv || (ov == bv && oi < gi)) { bv = ov; gi = oi; } }
        vs[k] = bv; es[k] = gi;
#pragma unroll
        for (int i = 0; i < 4; ++i) if (gi == 4 * s8 + i) v[i] = -3.4e38f;
    }
    float gs[4]; { float sum = 0.f;
#pragma unroll
        for (int k = 0; k < 4; ++k) { gs[k] = __expf(vs[k] - vs[0]); sum += gs[k]; }
        const float inv = 1.0f / sum;
#pragma unroll
        for (int k = 0; k < 4; ++k) gs[k] *= inv; }
    const int my_e = s8 == 0 ? es[0] : s8 == 1 ? es[1] : s8 == 2 ? es[2] : es[3]; const float my_g = s8 == 0 ? gs[0] : s8 == 1 ? gs[1] : s8 == 2 ? gs[2] : gs[3];
    int lp = 0;
    if (s8 < 4) lp = atomicAdd((int*)&hist[my_e], 1);
    R.issue(F.lane);
    __syncthreads();
    if (F.tid < 32) { const int hcount = hist[F.tid]; base[F.tid] = hcount ? (int)__hip_atomic_fetch_add((unsigned*)(ctl + CW_CNT + 64 * F.tid), (unsigned)hcount, RLX_AGENT) : 0; }
    __syncthreads();
    if (s8 < 4) {
        const int t = t0 + tk; unsigned* list = (unsigned*)(ws + SM_LIST); float* rsl = (float*)(ws + SM_RSLIST);
        unsigned* ts = (unsigned*)(ws + SM_TOKSLOT); float* gt = (float*)(ws + SM_GATE);
        const int pos = base[my_e] + lp; list[(size_t)my_e * CAP + pos] = (unsigned)t; rsl[(size_t)my_e * CAP + pos] = RS[tk];
        ts[t * 4 + s8] = ((unsigned)my_e << 16) | (unsigned)pos; gt[t * 4 + s8] = my_g;
    }
    R.retire(F.lane);
    __syncthreads();
}

__device__ __forceinline__ f32x4 fp8x4_to_f32(unsigned w) { const f32x2 lo = __builtin_amdgcn_cvt_pk_f32_fp8((int)w, false), hi = __builtin_amdgcn_cvt_pk_f32_fp8((int)w, true); return (f32x4){lo.x, lo.y, hi.x, hi.y}; }
__device__ __forceinline__ void combine_tile2(Frame& F, int b) {
    unsigned char* ws = F.ws;
    const LAS int* row_start = (const LAS int*)(F.lds + TAB_OFF) + 32 + 33;
    const unsigned* ts = (const unsigned*)(ws + SM_TOKSLOT); const float* gt = (const float*)(ws + SM_GATE); const unsigned char* Y2 = ws + WS_Y2;
    const int tw = 64 * b + 8 * F.wave;
    const u32x4 sl = *(const u32x4*)(ts + (tw + (F.lane & 7)) * 4); const f32x4 gl = *(const f32x4*)(gt + (tw + (F.lane & 7)) * 4) * (1.0f / YSCALE);
    const int r0 = row_start[sl.x >> 16] + (int)(sl.x & 0xffffu), r1 = row_start[sl.y >> 16] + (int)(sl.y & 0xffffu), r2 = row_start[sl.z >> 16] + (int)(sl.z & 0xffffu), r3 = row_start[sl.w >> 16] + (int)(sl.w & 0xffffu);
#pragma unroll
    for (int bt = 0; bt < 2; ++bt) {
        unsigned yv[4][4][4]; u32x2 hv[4][4];
#pragma unroll
        for (int i = 0; i < 4; ++i) { const int k = 4 * bt + i;
            const unsigned char* y0 = Y2 + (size_t)__builtin_amdgcn_readlane(r0, k) * D + 4 * F.lane; const unsigned char* y1 = Y2 + (size_t)__builtin_amdgcn_readlane(r1, k) * D + 4 * F.lane;
            const unsigned char* y2 = Y2 + (size_t)__builtin_amdgcn_readlane(r2, k) * D + 4 * F.lane; const unsigned char* y3 = Y2 + (size_t)__builtin_amdgcn_readlane(r3, k) * D + 4 * F.lane;
            const bf16* hq = (const bf16*)(ws + WS_HBF) + (size_t)(tw + k) * D + 4 * F.lane;
#pragma unroll
            for (int j = 0; j < 4; ++j) { yv[i][0][j] = __builtin_nontemporal_load((const unsigned*)(y0 + 256 * j)); yv[i][1][j] = __builtin_nontemporal_load((const unsigned*)(y1 + 256 * j));
                yv[i][2][j] = __builtin_nontemporal_load((const unsigned*)(y2 + 256 * j)); yv[i][3][j] = __builtin_nontemporal_load((const unsigned*)(y3 + 256 * j));
                hv[i][j] = __builtin_nontemporal_load((const u32x2*)(hq + 256 * j)); } }
#pragma unroll
        for (int i = 0; i < 4; ++i) { const int k = 4 * bt + i;
            const float g0 = __uint_as_float(__builtin_amdgcn_readlane(__float_as_uint(gl.x), k)), g1 = __uint_as_float(__builtin_amdgcn_readlane(__float_as_uint(gl.y), k));
            const float g2 = __uint_as_float(__builtin_amdgcn_readlane(__float_as_uint(gl.z), k)), g3 = __uint_as_float(__builtin_amdgcn_readlane(__float_as_uint(gl.w), k));
            float* op = F.out + (size_t)(tw + k) * D + 4 * F.lane;
#pragma unroll
            for (int j = 0; j < 4; ++j) { f32x4 o = (f32x4){bflo(hv[i][j].x), bfhi(hv[i][j].x), bflo(hv[i][j].y), bfhi(hv[i][j].y)};
                o += fp8x4_to_f32(yv[i][0][j]) * g0 + fp8x4_to_f32(yv[i][1][j]) * g1 + fp8x4_to_f32(yv[i][2][j]) * g2 + fp8x4_to_f32(yv[i][3][j]) * g3;
                *(f32x4*)(op + 256 * j) = o; } }
    }
}

constexpr int N_LAUNCHES = MK_N_LAUNCHES, PER_PHASE = 10, P1X_K = 8;
__global__ void __launch_bounds__(NTHR, 2) hymba_fwd(Args args) {
    extern __shared__ __attribute__((aligned(16))) unsigned char lds[];
    Frame F;
    F.lds = (LAS unsigned char*)lds;
    F.tid = threadIdx.x; F.lane = F.tid & 63; F.wave = __builtin_amdgcn_readfirstlane(F.tid >> 6);
    F.G = gridDim.x; F.bid = blockIdx.x; F.out = args.out; F.ws = args.ws;
    unsigned char* ws = args.ws;
    gu32* ctl = (gu32*)(ws + WS_CTL);
    for (int u = F.tid; u < (LDS_BYTES - LDSCTL_OFF) / 4; u += NTHR) ((LAS unsigned*)(F.lds + LDSCTL_OFF))[u] = 0u;
    __syncthreads();
    if (F.tid == 0) { LAS unsigned long long* pt = (LAS unsigned long long*)(F.lds + PTAB_OFF);
#pragma unroll
        for (int i = 0; i < 29; ++i) pt[i] = (unsigned long long)args.in[i]; }
    __syncthreads();
    const InTab in{(const LAS unsigned*)(F.lds + PTAB_OFF)};
    XcdBarrier bar; bar.bar = (unsigned*)(ctl + CW_BAR); bar.x = 0; bar.st = nullptr;
    if (N_LAUNCHES != PER_PHASE) bar = xcd_barrier_post((unsigned*)(ctl + CW_BAR), (volatile LAS unsigned*)(F.lds + MISC_OFF) + 8);
#define GRID_BAR(seam) do { if (N_LAUNCHES == PER_PHASE) { if (F.tid == 0) __hip_atomic_store(ctl + CW_TMO, 0xBADBA0u | (unsigned)(seam), RLX_AGENT); } else { xcd_barrier(bar); } } while (0)
    const int lo = args.ph_lo, hi = args.ph_hi;
#ifndef PH_MASK
#define PH_MASK 0x3ff
#endif
#define IN(k) (((PH_MASK >> (k)) & 1) && lo <= (k) && (k) < hi)
#define BOTH(k) (IN(k) && IN((k) + 1))
    LAS int* tab = (LAS int*)(F.lds + TAB_OFF);
#define REFRAME() do { int _t = threadIdx.x; asm volatile("" : "+v"(_t)); F.tid = _t; F.lane = _t & 63; F.wave = __builtin_amdgcn_readfirstlane(_t >> 6); } while (0)

    const int p1_units = (S / 256) * (D_INP / 256), p1_first_spare = p1_units - ((p1_units - 1) / F.G) * F.G, p1_spare = p1_first_spare < F.G ? F.G - p1_first_spare : 0;
    const int p1x = (p1_spare * NWAVES * P1X_K <= pg8::W1_PASSES / 2) ? p1_spare * NWAVES * P1X_K : 0, px0 = pg8::W1_PASSES - p1x;
    if (IN(0)) { REFRAME(); p0_prologue(F); if (BOTH(0)) GRID_BAR(0); }
    if (IN(1)) { REFRAME();
        pg8::SchedDense Sd; Sd.init(S, D_INP, F.G, F.bid, (const bf16*)(ws + WS_WIN));
        pg8::EpiInProj E{(bf16*)(ws + WS_U), (const float*)(ws + SM_RSTD1)};
        pg8::gemm_phase(F.lds, (const bf16*)(ws + WS_XB), (unsigned)S * D * 2u, Sd, E);
        if (p1x > 0 && F.bid >= p1_first_spare) { REFRAME(); pg8::W1Rider R; R.init_x(in[I_W1], ws + WS_W1, F.lds, F.wave, px0 + (F.bid - p1_first_spare) * NWAVES + F.wave, p1_spare * NWAVES, pg8::W1_PASSES); R.drain3(F.lane); }
        if (BOTH(1)) GRID_BAR(1);
    }
    if (IN(2)) { REFRAME();
        pg8::W1Rider R; R.init(in[I_W1], ws + WS_W1, F.lds, F.bid * NWAVES + F.wave, F.G * NWAVES, F.wave, 0, 5, px0);
        for (int b = F.bid; b < NTILE; b += F.G) { REFRAME(); swa_tile_mfma(F, b, R); }
        for (int b = F.bid; b < NTILE; b += F.G) { REFRAME(); mem_tile_mfma(F, b, R); }
        for (int b = F.bid; b < NTILE; b += F.G) { REFRAME(); lru_tile_mfma(F, b, R); }
        REFRAME(); R.drain(F.lane);
        if (BOTH(2)) GRID_BAR(2);
    }
    if (IN(3)) { REFRAME(); carry_scan(F); if (BOTH(3)) GRID_BAR(3); }
    if (IN(4)) { REFRAME();
        pg8::W1Rider R; R.init(in[I_W1], ws + WS_W1, F.lds, F.bid * NWAVES + F.wave, F.G * NWAVES, F.wave, 5, 7, px0);
        for (int b = F.bid; b < NTILE; b += F.G) { REFRAME(); lru_fix_tile(F, b, R); }
        REFRAME(); R.drain(F.lane);
        if (BOTH(4)) GRID_BAR(4);
    }
    if (IN(5)) { REFRAME();
        pg8::SchedDense Sd; Sd.init(S, D, F.G, F.bid, (const bf16*)(ws + WS_WOUT));
        pg8::EpiOutProj E{in[I_X], (bf16*)(ws + WS_HBF), ws + WS_HB, (float*)(ws + SM_SSQP), in[I_GFFN]};
        pg8::gemm_phase(F.lds, (const bf16*)(ws + WS_Y), (unsigned)S * D * 2u, Sd, E);
        if (BOTH(5)) GRID_BAR(5);
    }
    if (IN(6)) { REFRAME();
        pg8::W1Rider R; R.init(in[I_W1], ws + WS_W1, F.lds, F.bid * NWAVES + F.wave, F.G * NWAVES, F.wave, 7, 1 << 20, px0);
        for (int b = F.bid; b < NTILE; b += F.G) { REFRAME(); router_tile_mfma(F, b, R); }
        REFRAME(); R.drain3(F.lane);
        if (BOTH(6)) GRID_BAR(6);
    }
    if (IN(7)) { REFRAME();
        moe_tables(F);
        pg8::SchedMoE<true> Sm; Sm.NT = 8; Sm.G = F.G; Sm.c = F.bid; Sm.ntot = tab[32 + 32] * 8; Sm.Bt = (const bf16*)(ws + WS_W1); Sm.estride = (unsigned)FF2 * P8; Sm.Bbytes = 32u * FF2 * P8;
        Sm.cnt = tab; Sm.tile_start = tab + 32; Sm.row_start = tab + 65; Sm.mt_expert = tab + 97; Sm.list = (const unsigned*)(ws + SM_LIST);
        pg8::EpiMoE1 E{in[I_W2], ws + WS_W2, ws + WS_ACT, (const float*)(ws + SM_B1P), (const float*)(ws + SM_RSLIST), tab};
        pg8::gemm_phase(F.lds, (const bf16*)(ws + WS_HB), (unsigned)S * P8, Sm, E);
        if (BOTH(7)) GRID_BAR(7);
    }
    if (IN(8)) { REFRAME();
        moe_tables(F);
        pg8::SchedMoE<false> Sm; Sm.NT = 4; Sm.G = F.G; Sm.c = F.bid; Sm.ntot = tab[32 + 32] * 4; Sm.Bt = (const bf16*)(ws + WS_W2); Sm.estride = (unsigned)D * P8; Sm.Bbytes = 32u * D * P8;
        Sm.cnt = tab; Sm.tile_start = tab + 32; Sm.row_start = tab + 65; Sm.mt_expert = tab + 97; Sm.list = nullptr;
        pg8::EpiMoE2 E{ws + WS_Y2, in[I_B2]};
        pg8::gemm_phase(F.lds, (const bf16*)(ws + WS_ACT), (unsigned)MAXMT * 256u * P8, Sm, E);
        if (BOTH(8)) GRID_BAR(8);
    }
    if (IN(9)) { REFRAME();
        moe_tables(F);
        for (int b = F.bid; b < NTILE; b += F.G) combine_tile2(F, b);
    }
#undef IN
#undef BOTH
}

extern "C" void kernel_launch(void* const* d_in, const int* in_sizes, int n_in, void* d_out, int out_size, void* d_ws, size_t ws_size, hipStream_t stream) {
    static int grid = 0;
    if (grid == 0) {
        if (n_in != 29 || out_size != S * D || ws_size < WS_END) { fprintf(stderr, "kernel_launch: unexpected problem (n_in %d, out %d, ws %zu)\n", n_in, out_size, ws_size); grid = -1; return; }
        int dev = 0, cus = 0, per_cu = 0;
        if (hipGetDevice(&dev) != hipSuccess || hipDeviceGetAttribute(&cus, hipDeviceAttributeMultiprocessorCount, dev) != hipSuccess) { grid = -1; return; }
        if (hipFuncSetAttribute((const void*)hymba_fwd, hipFuncAttributeMaxDynamicSharedMemorySize, LDS_BYTES) != hipSuccess) { fprintf(stderr, "kernel_launch: hipFuncSetAttribute failed\n"); grid = -1; return; }
        if (hipOccupancyMaxActiveBlocksPerMultiprocessor(&per_cu, (const void*)hymba_fwd, NTHR, LDS_BYTES) != hipSuccess || per_cu < 1) fprintf(stderr, "kernel_launch: occupancy query reports %d\n", per_cu);
        (void)hipGetLastError();
        grid = cus;
    }
    if (grid < 0) return;
    if (hipMemsetAsync((char*)d_ws + WS_CTL, 0, CTL_ZERO_BYTES, stream) != hipSuccess) return;
    Args a{};
    for (int i = 0; i < 29; ++i) a.in[i] = (const float*)d_in[i];
    a.out = (float*)d_out; a.ws = (unsigned char*)d_ws;
    if (N_LAUNCHES == 1) { a.ph_lo = 0; a.ph_hi = PER_PHASE; hipLaunchKernelGGL(hymba_fwd, dim3(grid), dim3(NTHR), LDS_BYTES, stream, a); }
    else for (int li = 0; li < PER_PHASE; ++li) { a.ph_lo = li; a.ph_hi = li + 1; hipLaunchKernelGGL(hymba_fwd, dim3(grid), dim3(NTHR), LDS_BYTES, stream, a); }
}
```

```cpp
#include <hip/hip_runtime.h>
#include <cstdio>
#include <cstdint>

#ifndef MK_N_LAUNCHES
#define MK_N_LAUNCHES 1
#endif

#define LAS __attribute__((address_space(3)))
#define GAS __attribute__((address_space(1)))
typedef unsigned short bf16;
typedef short bf16x8 __attribute__((ext_vector_type(8)));
typedef float f32x4 __attribute__((ext_vector_type(4)));
typedef float f32x2 __attribute__((ext_vector_type(2)));
typedef unsigned u32x4 __attribute__((ext_vector_type(4)));
typedef unsigned u32x2 __attribute__((ext_vector_type(2)));
typedef GAS unsigned gu32;

constexpr int S = 16384, D = 1024, D_IN = 1664, D_INP = 1792, MEM_LEN = 256;
constexpr int OFF_LRU = 0, OFF_GATE = 384, OFF_Q = 768, OFF_K = 1152, OFF_V = 1280, OFF_QM = 1408;
constexpr int NE = 32, CAP = 16384, MAXMT = 288, FF2 = 2048;
constexpr float EPS = 1e-6f;
constexpr float YSCALE = 8.0f;
constexpr float WSCALE = 64.0f;
constexpr int P8 = 1152;
constexpr int NTILE = S / 64;

constexpr size_t MiB = 1u << 20;
constexpr size_t WS_CTL = 0, CTL_ZERO_BYTES = 1 * MiB;
constexpr size_t WS_WIN = 1 * MiB;
constexpr size_t WS_WOUT = 5 * MiB;
constexpr size_t WS_SMALL = 7 * MiB;
constexpr size_t SM_KM = WS_SMALL;
constexpr size_t SM_VM = SM_KM + 128 * 1024;
constexpr size_t SM_VMT = SM_VM + 128 * 1024;
constexpr size_t SM_WAT = SM_VMT + 128 * 1024;
constexpr size_t SM_WXT = SM_WAT + 64 * 1024;
constexpr size_t SM_AAGG = SM_WXT + 64 * 1024;
constexpr size_t SM_BAGG = SM_AAGG + 384 * 1024;
constexpr size_t SM_RSTD1 = SM_BAGG + 384 * 1024;
constexpr size_t SM_RSTD2 = SM_RSTD1 + 64 * 1024;
constexpr size_t SM_TOKSLOT = SM_RSTD2 + 64 * 1024;
constexpr size_t SM_GATE = SM_TOKSLOT + 256 * 1024;
constexpr size_t SM_SSQP = SM_GATE + 256 * 1024;
constexpr size_t SM_B1P = SM_SSQP + 1024 * 1024;
constexpr size_t SM_LIST = 12 * MiB;
constexpr size_t SM_RSLIST = 14 * MiB;
constexpr size_t SM_CARRY = SM_B1P + 256 * 1024;
constexpr size_t SM_WRH = SM_CARRY + 384 * 1024;
constexpr size_t SM_WRL = SM_WRH + 64 * 1024;
static_assert(SM_WRL + 64 * 1024 <= SM_LIST, "small map");
constexpr size_t WS_XB = 16 * MiB;
constexpr size_t WS_U = 48 * MiB;
constexpr size_t WS_Y = 104 * MiB;
constexpr size_t WS_HB = 136 * MiB;
constexpr size_t WS_YP = 648 * MiB;
constexpr size_t WS_W1 = 168 * MiB;
constexpr size_t WS_W2 = 296 * MiB;
constexpr size_t WS_ACT = 360 * MiB;
constexpr size_t WS_Y2 = 504 * MiB;
constexpr size_t WS_HBF = 672 * MiB;
constexpr size_t WS_END = 704 * MiB;
constexpr int CW_TMO = 0, CW_CODE = 1;
constexpr int CW_BAR = 4096;
constexpr int CW_CNT = 8192;

constexpr int RING_BYTES = 131072;
constexpr int LDSCTL_OFF = RING_BYTES, MISC_OFF = LDSCTL_OFF + 320;
constexpr int TAB_OFF = RING_BYTES + 1024;
constexpr int PTAB_OFF = RING_BYTES + 4096;
constexpr int LDS_BYTES = 147456;

__device__ __forceinline__ unsigned f2bf(float f) { unsigned u = __builtin_bit_cast(unsigned, f); return (u + 0x7fffu + ((u >> 16) & 1u)) >> 16; }
__device__ __forceinline__ unsigned pk2(float lo, float hi) { return f2bf(lo) | (f2bf(hi) << 16); }
__device__ __forceinline__ float bflo(unsigned w) { return __uint_as_float(w << 16); }
__device__ __forceinline__ float bfhi(unsigned w) { return __uint_as_float(w & 0xffff0000u); }
__device__ __forceinline__ float bf1(bf16 b) { return __uint_as_float(((unsigned)b) << 16); }
#define LDS_WAIT() asm volatile("s_waitcnt lgkmcnt(0)" ::: "memory")
#define VM_WAIT() asm volatile("s_waitcnt vmcnt(0)" ::: "memory")
#define RLX_AGENT __ATOMIC_RELAXED, __HIP_MEMORY_SCOPE_AGENT

namespace pg8 {
#define PG8_LAS __attribute__((address_space(3)))
constexpr int BM = 256, BK = 64, HALF = 128, HTB = HALF * BK * 2, STAGE_BYTES = 8 * HTB, NXCD = 8, WGM = 8, KD = 1024;
typedef int i32x4 __attribute__((ext_vector_type(4)));
typedef int i32x8 __attribute__((ext_vector_type(8)));
__device__ __forceinline__ float fp8_sat(float x) { return __builtin_fminf(__builtin_fmaxf(x, -448.0f), 448.0f); }
__device__ __forceinline__ unsigned pk4_fp8(float a, float b, float c, float d) { int w = 0; w = __builtin_amdgcn_cvt_pk_fp8_f32(fp8_sat(a), fp8_sat(b), w, false); w = __builtin_amdgcn_cvt_pk_fp8_f32(fp8_sat(c), fp8_sat(d), w, true); return (unsigned)w; }
constexpr int W2_PASSES = 32 * 16 * 32, W1_PASSES = 32 * 16 * 64, W2SCR_OFF = 131072 + 6144, W2SCR_WAVE = 1280;
template <bool IS1> __device__ __forceinline__ void wq_pass_load(f32x4 (&v)[2][4], const float* w, int q, int lane) {
    constexpr int N = IS1 ? 2048 : 1024, NBL = IS1 ? 6 : 5;
    const int e = q >> (4 + NBL), rem = q & ((16 << NBL) - 1), kb = rem >> NBL, nb = rem & ((1 << NBL) - 1); const float* W = w + (size_t)e * 1024 * N + (size_t)(64 * kb) * N + 32 * nb + 4 * (lane & 7);
#pragma unroll
    for (int grp = 0; grp < 2; ++grp)
#pragma unroll
        for (int ee = 0; ee < 4; ++ee) v[grp][ee] = __builtin_nontemporal_load((const f32x4*)(W + (size_t)(32 * grp + 4 * (lane >> 3) + ee) * N));
}
template <bool IS1> __device__ __forceinline__ void wq_pass_emit(const f32x4 (&v)[2][4], unsigned char* wt, int q, PG8_LAS unsigned char* scr, int lane, float scale) {
    constexpr int N = IS1 ? 2048 : 1024, NBL = IS1 ? 6 : 5;
    const int e = q >> (4 + NBL), rem = q & ((16 << NBL) - 1), kb = rem >> NBL, nb = rem & ((1 << NBL) - 1), r = lane >> 3, c = lane & 7;
    unsigned w[4][2];
#pragma unroll
    for (int comp = 0; comp < 4; ++comp)
#pragma unroll
        for (int grp = 0; grp < 2; ++grp) w[comp][grp] = pk4_fp8(v[grp][0][comp] * scale, v[grp][1][comp] * scale, v[grp][2][comp] * scale, v[grp][3][comp] * scale);
    unsigned char* dst = wt + (size_t)e * N * P8 + 64 * kb;
#pragma unroll
    for (int hh = 0; hh < 2; ++hh) {
        if ((c >> 2) == hh) {
#pragma unroll
            for (int comp = 0; comp < 4; ++comp)
#pragma unroll
                for (int grp = 0; grp < 2; ++grp) *(PG8_LAS unsigned*)(scr + (4 * (c & 3) + comp) * 80 + (8 * grp + r) * 4) = w[comp][grp];
        }
        asm volatile("s_waitcnt lgkmcnt(0)" ::: "memory");
        const u32x4 o = *(const PG8_LAS u32x4*)(scr + (lane >> 2) * 80 + (lane & 3) * 16);
        int nn = 32 * nb + 16 * hh + (lane >> 2); if (IS1) { const int a = nn >> 1, s1 = nn & 1; nn = 256 * (a >> 7) + 128 * s1 + (a & 127); }
        *(u32x4*)(dst + (size_t)nn * P8 + 16 * (lane & 3)) = o;
        asm volatile("s_waitcnt lgkmcnt(0)" ::: "memory");
    }
}
__device__ __forceinline__ void w2_pass_load(f32x4 (&v)[2][4], const float* w2, int q, int lane) { wq_pass_load<false>(v, w2, q, lane); }
__device__ __forceinline__ void w2_pass_load_grp(f32x4 (&v)[2][4], const float* w2, int q, int lane, int grp) {
    const int e = q >> 9, rem = q & 511, kb = rem >> 5, nb = rem & 31; const float* W = w2 + (size_t)e * 1024 * 1024 + (size_t)(64 * kb) * 1024 + 32 * nb + 4 * (lane & 7);
#pragma unroll
    for (int ee = 0; ee < 4; ++ee) v[grp][ee] = __builtin_nontemporal_load((const f32x4*)(W + (size_t)(32 * grp + 4 * (lane >> 3) + ee) * 1024));
}
__device__ __forceinline__ void w2_pass_emit(const f32x4 (&v)[2][4], unsigned char* w2t, int q, PG8_LAS unsigned char* scr, int lane, float scale) { wq_pass_emit<false>(v, w2t, q, scr, lane, scale); }
struct W1Rider { const float* w1; unsigned char* w1t; PG8_LAS unsigned char* scr; int q, qstep, qlive, qend; f32x4 v[2][4];
    __device__ __forceinline__ void init(const float* w1_, unsigned char* w1t_, PG8_LAS unsigned char* lds, int gw, int ngw, int wid, int j0, int j1, int qcap) { w1 = w1_; w1t = w1t_; scr = lds + W2SCR_OFF + wid * W2SCR_WAVE; q = gw + ngw * j0; qstep = ngw; qlive = -1; const long long e = (long long)gw + (long long)ngw * j1; qend = e < qcap ? (int)e : qcap; }
    __device__ __forceinline__ void init_x(const float* w1_, unsigned char* w1t_, PG8_LAS unsigned char* lds, int wid, int q0, int step, int qe) { w1 = w1_; w1t = w1t_; scr = lds + W2SCR_OFF + wid * W2SCR_WAVE; q = q0; qstep = step; qlive = -1; qend = qe; }
    __device__ __forceinline__ void issue(int lane) { if (q < qend) { wq_pass_load<true>(v, w1, q, lane); qlive = q; q += qstep; } else qlive = -1; }
    __device__ __forceinline__ void retire(int lane) { if (qlive >= 0) wq_pass_emit<true>(v, w1t, qlive, scr, lane, WSCALE); qlive = -1; }
    __device__ __forceinline__ void ride(int lane) { if (qlive >= 0) wq_pass_emit<true>(v, w1t, qlive, scr, lane, WSCALE); if (q < qend) { wq_pass_load<true>(v, w1, q, lane); qlive = q; q += qstep; } else qlive = -1; }
    __device__ __forceinline__ void drain(int lane) { if (qlive < 0) ride(lane); while (qlive >= 0) ride(lane); }
    __device__ __forceinline__ void drain3(int lane) {
        retire(lane);
        f32x4 va[2][4], vb[2][4]; int qa = -1, qb = -1, qc = -1;
        if (q < qend) { qa = q; q += qstep; wq_pass_load<true>(va, w1, qa, lane); }
        if (q < qend) { qb = q; q += qstep; wq_pass_load<true>(vb, w1, qb, lane); }
        while (qa >= 0) {
            if (q < qend) { qc = q; q += qstep; wq_pass_load<true>(v, w1, qc, lane); } else qc = -1;
            wq_pass_emit<true>(va, w1t, qa, scr, lane, WSCALE);
#pragma unroll
            for (int g2 = 0; g2 < 2; ++g2)
#pragma unroll
                for (int e2 = 0; e2 < 4; ++e2) { va[g2][e2] = vb[g2][e2]; vb[g2][e2] = v[g2][e2]; }
            qa = qb; qb = qc;
        }
    }
};
__host__ __device__ __forceinline__ int lds_byte(int r, int c) { const int st = (r >> 4) * 2 + (c >> 5), rr = r & 15, cc = c & 31, ob = rr * 64 + cc * 2; return st * 1024 + (ob ^ (((ob >> 9) & 1) << 5)); }
__host__ __device__ __forceinline__ void stage_rc(int b, int& R, int& C) { const int st = b / 1024, sb = b % 1024, swz = sb ^ (((sb >> 9) & 1) << 5); R = (st >> 1) * 16 + swz / 64; C = (st & 1) * 32 + (swz % 64) / 2; }
__host__ __device__ __forceinline__ int perm32(int rho) { const int n = rho >> 4, i = rho & 15; return 8 * (i >> 2) + 4 * n + (i & 3); }
__device__ __forceinline__ unsigned cvt_pk_bf16(float lo, float hi) { unsigned r; asm volatile("v_cvt_pk_bf16_f32 %0, %1, %2" : "=v"(r) : "v"(lo), "v"(hi)); return r; }

struct Unit { int pm, pn, e, rowbase; };

struct SchedDense {
    int nM, nN, nwg, G, c; const bf16* Bt; unsigned Bbytes;
    __device__ void init(int M, int N, int G_, int c_, const bf16* Bt_) { nM = M / BM; nN = N / BM; nwg = nM * nN; G = G_; c = c_; Bt = Bt_; Bbytes = (unsigned)N * KD * 2; }
    __device__ bool next(int i, Unit& u) const {
        const long L = (long)i * G + c; if (L >= nwg) return false;
        int wgid = (int)L; { const int q = nwg / NXCD, r = nwg % NXCD, xcd = wgid % NXCD, off = wgid / NXCD; wgid = (xcd < r ? xcd * (q + 1) : r * (q + 1) + (xcd - r) * q) + off; }
        const int nig = WGM * nN, gid = wgid / nig, fm = gid * WGM, gsz = (nM - fm) < WGM ? (nM - fm) : WGM;
        u.pm = fm + ((wgid % nig) % gsz); u.pn = (wgid % nig) / gsz; u.e = 0; u.rowbase = u.pm * BM; return true;
    }
    __device__ __forceinline__ unsigned arow(const Unit& u, int r) const { return (unsigned)(u.pm * BM + r); }
    __device__ __forceinline__ unsigned bbase(const Unit& u) const { return (unsigned)u.pn * (unsigned)(BM * KD * 2); }
    static constexpr bool GATHER = false;
    __device__ __forceinline__ unsigned abase(const Unit& u) const { return (unsigned)u.rowbase; }
};
template <bool GATHER_> struct SchedMoE {
    static constexpr bool GATHER = GATHER_;
    __device__ __forceinline__ unsigned abase(const Unit& u) const { return (unsigned)u.rowbase; }
    int NT, G, c, ntot; const bf16* Bt; unsigned Bbytes; unsigned estride;
    const PG8_LAS int* cnt; const PG8_LAS int* tile_start; const PG8_LAS int* row_start; const PG8_LAS int* mt_expert;
    const unsigned* list;
    __device__ bool next(int i, Unit& u) const {
        int mtg;
        if (G == 256) {
            const int x = c & 7, q = c >> 3, nsub = NT >> 2, item = i * 8 + x, chunk = item / nsub, hlf = item - chunk * nsub;
            mtg = chunk * 8 + (q & 7); u.pn = hlf * 4 + (q >> 3);
            if (mtg * NT >= ntot) return false;
        } else { const int L = i * G + c; if (L >= ntot) return false; mtg = L / NT; u.pn = L - mtg * NT; } u.e = __builtin_amdgcn_readfirstlane(mt_expert[mtg]); u.pm = mtg - __builtin_amdgcn_readfirstlane(tile_start[u.e]); u.rowbase = __builtin_amdgcn_readfirstlane(row_start[u.e]) + u.pm * BM; return true;
    }
    __device__ __forceinline__ unsigned arow(const Unit& u, int r) const {
        const int pos = min(u.pm * BM + r, cnt[u.e] - 1); return list[(size_t)u.e * CAP + pos];
    }
    __device__ __forceinline__ unsigned bbase(const Unit& u) const { return (unsigned)u.e * estride + (unsigned)u.pn * (unsigned)(BM * P8); }
};

struct EpiInProj {
    static constexpr bool LDSEPI = false;
    static constexpr bool RIDER = false;
    static constexpr bool PERM = true, FP8 = false;
    bf16* U; const float* rstd;
    __device__ __forceinline__ void operator()(const f32x4 (&acc)[2][2][4][2], const Unit& u, int wr, int wc, int fr, int fq) const {
        const int row0 = u.rowbase + wr * 64 + fr, col0 = u.pn * BM + wc * 32 + 8 * fq;
        float rsv[2][4];
#pragma unroll
        for (int ai = 0; ai < 2; ++ai)
#pragma unroll
            for (int m = 0; m < 4; ++m) rsv[ai][m] = rstd[row0 + ai * HALF + m * 16];
#pragma unroll
        for (int ai = 0; ai < 2; ++ai)
#pragma unroll
            for (int m = 0; m < 4; ++m) { const int row = row0 + ai * HALF + m * 16; const float rs = rsv[ai][m]; bf16* rowp = U + (size_t)row * D_INP + col0;
#pragma unroll
                for (int bj = 0; bj < 2; ++bj) { const f32x4 v0 = acc[ai][bj][m][0] * rs, v1 = acc[ai][bj][m][1] * rs;
                    u32x4 w; w.x = cvt_pk_bf16(v0[0], v0[1]); w.y = cvt_pk_bf16(v0[2], v0[3]); w.z = cvt_pk_bf16(v1[0], v1[1]); w.w = cvt_pk_bf16(v1[2], v1[3]);
                    *(u32x4*)(rowp + bj * HALF) = w; } }
    }
};
struct EpiOutProj {
    static constexpr bool LDSEPI = false;
    static constexpr bool RIDER = false;
    static constexpr bool PERM = true, FP8 = false;
    const float* x; bf16* hbf; unsigned char* HB8; float* ssqp; const float* gffn;
    __device__ __forceinline__ void xload(f32x4 (&xv)[2][2][2], int row0, int col0, int ai, int mp) const {
#pragma unroll
        for (int mm = 0; mm < 2; ++mm)
#pragma unroll
            for (int bj = 0; bj < 2; ++bj) { const size_t o = (size_t)(row0 + ai * HALF + (2 * mp + mm) * 16) * D + col0 + bj * HALF;
                xv[mm][bj][0] = __builtin_nontemporal_load((const f32x4*)(x + o)); xv[mm][bj][1] = __builtin_nontemporal_load((const f32x4*)(x + o + 4)); }
    }
    __device__ __forceinline__ void operator()(const f32x4 (&acc)[2][2][4][2], const Unit& u, int wr, int wc, int fr, int fq) const {
        const int row0 = u.rowbase + wr * 64 + fr, col0 = u.pn * BM + wc * 32 + 8 * fq;
        f32x4 gf[2][2];
#pragma unroll
        for (int bj = 0; bj < 2; ++bj) { gf[bj][0] = *(const f32x4*)(gffn + col0 + bj * HALF); gf[bj][1] = *(const f32x4*)(gffn + col0 + bj * HALF + 4); }
        f32x4 xv[2][2][2][2];
        xload(xv[0], row0, col0, 0, 0);
#pragma unroll
        for (int b = 0; b < 4; ++b) { const int ai = b >> 1, mp = b & 1;
            if (b < 3) xload(xv[(b + 1) & 1], row0, col0, (b + 1) >> 1, (b + 1) & 1);
#pragma unroll
            for (int mm = 0; mm < 2; ++mm) { const int m = 2 * mp + mm, row = row0 + ai * HALF + m * 16; const size_t off = (size_t)row * D + col0; float sq = 0.f;
#pragma unroll
                for (int bj = 0; bj < 2; ++bj) { const size_t o = off + bj * HALF; const f32x4 h0 = xv[b & 1][mm][bj][0] + acc[ai][bj][m][0], h1 = xv[b & 1][mm][bj][1] + acc[ai][bj][m][1];
                    { u32x4 hw; hw.x = cvt_pk_bf16(h0[0], h0[1]); hw.y = cvt_pk_bf16(h0[2], h0[3]); hw.z = cvt_pk_bf16(h1[0], h1[1]); hw.w = cvt_pk_bf16(h1[2], h1[3]); *(u32x4*)(hbf + o) = hw; }
                    const f32x4 s0 = h0 * gf[bj][0], s1 = h1 * gf[bj][1]; u32x2 w; w.x = pk4_fp8(s0[0], s0[1], s0[2], s0[3]); w.y = pk4_fp8(s1[0], s1[1], s1[2], s1[3]); *(u32x2*)(HB8 + (size_t)row * P8 + col0 + bj * HALF) = w;
                    sq += ((h0[0] * h0[0] + h0[1] * h0[1]) + (h0[2] * h0[2] + h0[3] * h0[3])) + ((h1[0] * h1[0] + h1[1] * h1[1]) + (h1[2] * h1[2] + h1[3] * h1[3])); }
                sq += __shfl_xor(sq, 16); sq += __shfl_xor(sq, 32);
                if (fq == 0) ssqp[(size_t)row * 16 + u.pn * 4 + wc] = sq; } }
    }
};
struct EpiMoE1 {
    static constexpr bool LDSEPI = false;
    static constexpr bool RIDER = true; const float* w2; unsigned char* w2t;
    static constexpr bool PERM = true, FP8 = true;
    unsigned char* ACT; const float* b1p; const float* rslist; const PG8_LAS int* cnt;
    struct Pre { f32x4 bg0, bg1, bl0, bl1; float rsv[2][4]; };
    __device__ __forceinline__ void prep(const Unit& u, int wr, int wc, int fr, int fq, Pre& p) const {
        const int r0 = wr * 64 + fr, cb = wc * 32 + 8 * fq; const int last = cnt[u.e] - 1 - u.pm * BM;
        const float* bp = b1p + (size_t)u.e * FF2 + u.pn * BM + cb; const float* rsp = rslist + (size_t)u.e * CAP + u.pm * BM;
        p.bg0 = *(const f32x4*)(bp); p.bg1 = *(const f32x4*)(bp + 4); p.bl0 = *(const f32x4*)(bp + HALF); p.bl1 = *(const f32x4*)(bp + HALF + 4);
#pragma unroll
        for (int ai = 0; ai < 2; ++ai)
#pragma unroll
            for (int m = 0; m < 4; ++m) p.rsv[ai][m] = rsp[min(r0 + ai * HALF + m * 16, last)] * (1.0f / WSCALE);
    }
    __device__ __forceinline__ void operator()(const f32x4 (&acc)[2][2][4][2], const Unit& u, int wr, int wc, int fr, int fq) const { Pre p; prep(u, wr, wc, fr, fq, p); half(acc, u, wr, wc, fr, fq, 0, p); half(acc, u, wr, wc, fr, fq, 1, p); }
    __device__ __forceinline__ void half(const f32x4 (&acc)[2][2][4][2], const Unit& u, int wr, int wc, int fr, int fq, const int ai, const Pre& p) const {
        const int r0 = wr * 64 + fr, cb = wc * 32 + 8 * fq;
        const f32x4 bg0 = p.bg0, bg1 = p.bg1, bl0 = p.bl0, bl1 = p.bl1;
#pragma unroll
            for (int m = 0; m < 4; ++m) { const int r = r0 + ai * HALF + m * 16; const float rs = p.rsv[ai][m];
                const f32x4 g0 = acc[ai][0][m][0] * rs + bg0, g1 = acc[ai][0][m][1] * rs + bg1, l0 = acc[ai][1][m][0] * rs + bl0, l1 = acc[ai][1][m][1] * rs + bl1;
                float o[8];
#pragma unroll
                for (int j = 0; j < 8; ++j) { const float g = fminf(j < 4 ? g0[j & 3] : g1[j & 3], 7.0f); const float l = fminf(fmaxf(j < 4 ? l0[j & 3] : l1[j & 3], -7.0f), 7.0f);
                    o[j] = g * __builtin_amdgcn_rcpf(1.0f + __expf(-1.702f * g)) * (l + 1.0f); }
                u32x2 w; w.x = pk4_fp8(o[0], o[1], o[2], o[3]); w.y = pk4_fp8(o[4], o[5], o[6], o[7]);
                *(u32x2*)(ACT + (size_t)(u.rowbase + r) * P8 + u.pn * HALF + cb) = w; }
    }
};
struct EpiMoE2 {
    static constexpr bool PERM = true, FP8 = true;
    static constexpr int RIDER = 0; static constexpr bool LDSEPI = true;
    unsigned char* Y2; const float* b2;
    __device__ __forceinline__ void operator()(const f32x4 (&acc)[2][2][4][2], const Unit& u, int wr, int wc, int fr, int fq, PG8_LAS unsigned char* lds, int tid) const {
        PG8_LAS unsigned char* buf = lds + 3 * HTB;
        const int col0 = u.pn * BM + wc * 32 + 8 * fq;
        f32x4 bv[2][2];
#pragma unroll
        for (int bj = 0; bj < 2; ++bj)
#pragma unroll
            for (int n = 0; n < 2; ++n) bv[bj][n] = *(const f32x4*)(b2 + (size_t)u.e * D + col0 + bj * HALF + 4 * n) * YSCALE;
#pragma unroll
        for (int s = 0; s < 4; ++s) {
            const int ai = s >> 1;
            if (wr == (s & 1)) {
#pragma unroll
                for (int m = 0; m < 4; ++m) { const int row = 16 * m + fr;
#pragma unroll
                    for (int bj = 0; bj < 2; ++bj) { const f32x4 v0 = acc[ai][bj][m][0] * (YSCALE / WSCALE) + bv[bj][0], v1 = acc[ai][bj][m][1] * (YSCALE / WSCALE) + bv[bj][1];
                        u32x2 w; w.x = pk4_fp8(v0[0], v0[1], v0[2], v0[3]); w.y = pk4_fp8(v1[0], v1[1], v1[2], v1[3]);
                        const int ch = 8 * bj + 2 * wc + (fq >> 1);
                        *(PG8_LAS u32x2*)(buf + row * 256 + ((ch ^ fr) << 4) + 8 * (fq & 1)) = w; } }
            }
            asm volatile("s_waitcnt lgkmcnt(0)" ::: "memory"); __builtin_amdgcn_s_barrier(); asm volatile("" ::: "memory");
#pragma unroll
            for (int k = 0; k < 2; ++k) { const int ci = tid + 512 * k, row = ci >> 4, ch = ci & 15;
                const u32x4 o = *(const PG8_LAS u32x4*)(buf + row * 256 + ((ch ^ (row & 15)) << 4));
                __builtin_nontemporal_store(o, (u32x4*)(Y2 + (size_t)(u.rowbase + 64 * s + row) * D + u.pn * BM + 16 * ch)); }
            asm volatile("s_waitcnt lgkmcnt(0)" ::: "memory"); __builtin_amdgcn_s_barrier(); asm volatile("" ::: "memory");
        }
    }
};

template <class Epi, class Sched>
__device__ __forceinline__ void gemm_phase(PG8_LAS unsigned char* lds, const bf16* Abase, unsigned Abytes, const Sched& S, const Epi& E) {
    int tid = threadIdx.x; asm volatile("" : "+v"(tid));
    const int wid = __builtin_amdgcn_readfirstlane(tid >> 6), lane = tid & 63, wr = wid >> 2, wc = wid & 3, fr = lane & 15, fq = lane >> 4;
    constexpr bool FP8 = Epi::FP8; constexpr int PITCH = FP8 ? P8 : KD * 2; constexpr int nt = FP8 ? KD / 128 : KD / BK;
    int R0, C0; stage_rc(tid * 16, R0, C0);
    unsigned voffB[2];
#pragma unroll
    for (int i = 0; i < 2; ++i) { const int R = R0 + 64 * i; const int Rb = Epi::PERM ? ((R & ~31) + perm32(R & 31)) : R; voffB[i] = (unsigned)(Rb * PITCH + C0 * 2); }
    constexpr unsigned kstep = (unsigned)(BK * 2);
    constexpr unsigned hstep = (unsigned)HALF * PITCH;
    const unsigned ldsw = (unsigned)wid * 1024u;
    const int aoff = lds_byte(wr * 64 + fr, fq * 8), boff = lds_byte(wc * 32 + fr, fq * 8);
    const __amdgpu_buffer_rsrc_t rsA = __builtin_amdgcn_make_buffer_rsrc((void*)Abase, (short)0, (int)Abytes, 0x00020000);
    const __amdgpu_buffer_rsrc_t rsB = __builtin_amdgcn_make_buffer_rsrc((void*)S.Bt, (short)0, (int)S.Bbytes, 0x00020000);
#define PG8_SA(b, h) (((b) * 2 + (h)) * HTB)
#define PG8_SB(b, h) ((4 + (b) * 2 + (h)) * HTB)
#define PG8_STAGE(bufoff, soff, voff) do { _Pragma("unroll") for (int _i = 0; _i < 2; ++_i) \
        __builtin_amdgcn_raw_ptr_buffer_load_lds(rsB, (PG8_LAS void*)(lds + (bufoff) + ldsw + _i * 8192), 16, (int)(voff)[_i], (int)(soff), 0, 0); } while (0)
#define PG8_STAGEA(bufoff, H, kb, NEXT) do { \
        if constexpr (Sched::GATHER) { const unsigned _tk = (NEXT) ? ((H) ? nt1 : nt0) : ((H) ? ct1 : ct0); \
            __builtin_amdgcn_raw_ptr_buffer_load_lds(rsA, (PG8_LAS void*)(lds + (bufoff) + ldsw), 16, (int)((_tk & 0xffffu) * (unsigned)PITCH + (unsigned)(C0 * 2)), (int)(kb), 0, 0); \
            __builtin_amdgcn_raw_ptr_buffer_load_lds(rsA, (PG8_LAS void*)(lds + (bufoff) + ldsw + 8192), 16, (int)((_tk >> 16) * (unsigned)PITCH + (unsigned)(C0 * 2)), (int)(kb), 0, 0); } \
        else { const unsigned _sb = ((NEXT) ? nA : cA) + (H) * hstep + (kb); \
            __builtin_amdgcn_raw_ptr_buffer_load_lds(rsA, (PG8_LAS void*)(lds + (bufoff) + ldsw), 16, (int)voffA0, (int)_sb, 0, 0); \
            __builtin_amdgcn_raw_ptr_buffer_load_lds(rsA, (PG8_LAS void*)(lds + (bufoff) + ldsw + 8192), 16, (int)voffA0, (int)(_sb + 64u * PITCH), 0, 0); } } while (0)
#define PG8_LDA(dst, b, h) do { _Pragma("unroll") for (int m = 0; m < 4; ++m) _Pragma("unroll") for (int k = 0; k < 2; ++k) dst[m][k] = *(const PG8_LAS bf16x8*)(lds + PG8_SA(b, h) + aoff + m * 2048 + k * 1024); } while (0)
#define PG8_LDB(dst, b, h) do { _Pragma("unroll") for (int n = 0; n < 2; ++n) _Pragma("unroll") for (int k = 0; k < 2; ++k) dst[n][k] = *(const PG8_LAS bf16x8*)(lds + PG8_SB(b, h) + boff + n * 2048 + k * 1024); } while (0)
#define PG8_CAT(f) __builtin_shufflevector(__builtin_bit_cast(i32x4, (f)[0]), __builtin_bit_cast(i32x4, (f)[1]), 0, 1, 2, 3, 4, 5, 6, 7)
#define PG8_MMA(ai, bj, At, Bt) do { __builtin_amdgcn_s_setprio(1); _Pragma("unroll") for (int m = 0; m < 4; ++m) _Pragma("unroll") for (int n = 0; n < 2; ++n) { \
        if constexpr (FP8) { const i32x8 _b = PG8_CAT(Bt[n]), _a = PG8_CAT(At[m]); asm volatile("v_mfma_scale_f32_16x16x128_f8f6f4 %0, %1, %2, %0, %3, %3 op_sel_hi:[0,0,0]" : "+v"(acc[ai][bj][m][n]) : "v"(_b), "v"(_a), "v"(scale1)); }   \
        else { _Pragma("unroll") for (int k = 0; k < 2; ++k) acc[ai][bj][m][n] = __builtin_amdgcn_mfma_f32_16x16x32_bf16(Bt[n][k], At[m][k], acc[ai][bj][m][n], 0, 0, 0); } } \
        __builtin_amdgcn_s_setprio(0); } while (0)
#define PG8_WAIT_V(n) asm volatile("s_waitcnt vmcnt(" #n ")" ::: "memory")
#define PG8_WAIT_L(n) asm volatile("s_waitcnt lgkmcnt(" #n ")" ::: "memory")
#define PG8_BAR __builtin_amdgcn_s_barrier()
#define PG8_SCHED __builtin_amdgcn_sched_barrier(0)
#define PG8_TOK2(u, h) (S.arow(u, (h) * HALF + R0) | (S.arow(u, (h) * HALF + R0 + 64) << 16))
    Unit cur, nxt; int ui = 0;
    if (!S.next(0, cur)) {
        if constexpr (Epi::RIDER) { for (int u2 = 0; ; ++u2) { const int q = (u2 * (int)gridDim.x + (int)blockIdx.x) * 8 + wid; if (q >= W2_PASSES) break;
            f32x4 rv[2][4]; w2_pass_load(rv, E.w2, q, lane); w2_pass_emit(rv, E.w2t, q, lds + W2SCR_OFF + wid * W2SCR_WAVE, lane, WSCALE); } }
        return; }
    f32x4 acc[2][2][4][2];
#pragma unroll
    for (int a = 0; a < 2; ++a)
#pragma unroll
        for (int b = 0; b < 2; ++b)
#pragma unroll
            for (int m = 0; m < 4; ++m)
#pragma unroll
                for (int n = 0; n < 2; ++n) acc[a][b][m][n] = (f32x4){0.f, 0.f, 0.f, 0.f};
    bf16x8 At[4][2], B0[2][2], B1[2][2];
    const int scale1 = 0x7F7F7F7F;
    const unsigned voffA0 = (unsigned)(R0 * PITCH + C0 * 2);
    unsigned ct0 = 0, ct1 = 0, nt0 = 0, nt1 = 0, cA = 0, nA = 0;
    if constexpr (Sched::GATHER) { ct0 = PG8_TOK2(cur, 0); ct1 = PG8_TOK2(cur, 1); } else cA = S.abase(cur) * (unsigned)PITCH;
    unsigned cB = S.bbase(cur);
    PG8_STAGE(PG8_SB(0, 0), cB, voffB); PG8_STAGE(PG8_SB(0, 1), cB + hstep, voffB); PG8_STAGEA(PG8_SA(0, 0), 0, 0u, false); PG8_STAGEA(PG8_SA(0, 1), 1, 0u, false);
    if (wr == 1) PG8_BAR;
    PG8_WAIT_V(2); PG8_BAR;
    PG8_STAGE(PG8_SB(1, 0), cB + kstep, voffB); PG8_STAGEA(PG8_SA(1, 0), 0, kstep, false); PG8_STAGE(PG8_SB(1, 1), cB + hstep + kstep, voffB);
    PG8_WAIT_V(6); PG8_BAR;
    for (;;) {
        const bool has_next = S.next(ui + 1, nxt);
        const unsigned nB = has_next ? S.bbase(nxt) : cB;
#define PG8_KBODY(LAST, t) do { \
            const unsigned kb1 = (unsigned)((t) + 1) * kstep; \
            const unsigned kb2 = (LAST) ? 0u : (unsigned)((t) + 2) * kstep; \
            const unsigned b2 = (LAST) ? nB : cB + (unsigned)((t) + 2) * kstep; const unsigned b3 = b2 + kstep; \
              \
            PG8_LDB(B0, 0, 0); PG8_LDB(B1, 0, 1); PG8_SCHED; PG8_LDA(At, 0, 0); PG8_STAGEA(PG8_SA(1, 1), 1, kb1, false); \
            PG8_WAIT_V(8); PG8_WAIT_L(0); PG8_BAR; PG8_MMA(0, 0, At, B0); PG8_MMA(0, 1, At, B1); PG8_BAR; PG8_SCHED; \
              \
            PG8_LDA(At, 0, 1); PG8_STAGE(PG8_SB(0, 0), b2, voffB); PG8_STAGE(PG8_SB(0, 1), b2 + hstep, voffB); PG8_STAGEA(PG8_SA(0, 0), 0, kb2, (LAST)); \
            PG8_WAIT_V(8); PG8_WAIT_L(0); PG8_BAR; PG8_MMA(1, 0, At, B0); PG8_MMA(1, 1, At, B1); PG8_BAR; PG8_SCHED; \
              \
            PG8_LDB(B0, 1, 0); PG8_LDB(B1, 1, 1); PG8_SCHED; PG8_LDA(At, 1, 0); PG8_STAGEA(PG8_SA(0, 1), 1, kb2, (LAST)); \
            PG8_WAIT_V(8); PG8_WAIT_L(0); PG8_BAR; PG8_MMA(0, 0, At, B0); PG8_MMA(0, 1, At, B1); PG8_BAR; PG8_SCHED; \
              \
            PG8_LDA(At, 1, 1); PG8_STAGE(PG8_SB(1, 0), b3, voffB); PG8_STAGE(PG8_SB(1, 1), b3 + hstep, voffB); PG8_STAGEA(PG8_SA(1, 0), 0, kb2 + kstep, (LAST)); \
            PG8_WAIT_V(8); PG8_WAIT_L(0); PG8_BAR; PG8_MMA(1, 0, At, B0); PG8_MMA(1, 1, At, B1); PG8_BAR; PG8_SCHED; \
        } while (0)
#pragma unroll 1
        for (int t = 0; t < nt; t += 2) {
            const bool last = (t == nt - 2);
            if (last) { if constexpr (Sched::GATHER) { if (has_next) { nt0 = PG8_TOK2(nxt, 0); nt1 = PG8_TOK2(nxt, 1); } else { nt0 = ct0; nt1 = ct1; } } else nA = has_next ? S.abase(nxt) * (unsigned)PITCH : cA; }
            PG8_KBODY(last, t);
        }
        if constexpr (FP8) asm volatile("s_nop 15\n\ts_nop 15\n\ts_nop 7" ::: "memory");
        if (wr == 0) PG8_BAR;
        if constexpr (Epi::RIDER) {
            int tl = tid; asm volatile("" : "+v"(tl)); const int ln = tl & 63; const int q = (ui * (int)gridDim.x + (int)blockIdx.x) * 8 + wid;
            f32x4 rv[2][4]; const bool ride = q < W2_PASSES;
            typename Epi::Pre pre; E.prep(cur, wr, wc, tl & 15, (tl & 63) >> 4, pre);
            if (ride) w2_pass_load_grp(rv, E.w2, q, ln, 0);
            E.half(acc, cur, wr, wc, tl & 15, (tl & 63) >> 4, 0, pre);
            if (ride) w2_pass_load_grp(rv, E.w2, q, ln, 1);
            E.half(acc, cur, wr, wc, tl & 15, (tl & 63) >> 4, 1, pre);
            if (ride) w2_pass_emit(rv, E.w2t, q, lds + W2SCR_OFF + wid * W2SCR_WAVE, ln, WSCALE);
        } else
        { int tl = tid; asm volatile("" : "+v"(tl)); if constexpr (Epi::LDSEPI) E(acc, cur, wr, wc, tl & 15, (tl & 63) >> 4, lds, tl); else E(acc, cur, wr, wc, tl & 15, (tl & 63) >> 4); }
        if (!has_next) break;
#pragma unroll
        for (int a = 0; a < 2; ++a)
#pragma unroll
            for (int b = 0; b < 2; ++b)
#pragma unroll
                for (int m = 0; m < 4; ++m)
#pragma unroll
                    for (int n = 0; n < 2; ++n) acc[a][b][m][n] = (f32x4){0.f, 0.f, 0.f, 0.f};
        cur = nxt; cB = nB; ct0 = nt0; ct1 = nt1; cA = nA; ++ui;
        if (wr == 1) PG8_BAR;
    }
    PG8_WAIT_V(0);
    PG8_BAR;
    if constexpr (Epi::RIDER) {
        for (int u2 = ui + 1; ; ++u2) { const int q = (u2 * (int)gridDim.x + (int)blockIdx.x) * 8 + wid; if (q >= W2_PASSES) break;
            f32x4 rv[2][4]; w2_pass_load(rv, E.w2, q, lane); w2_pass_emit(rv, E.w2t, q, lds + W2SCR_OFF + wid * W2SCR_WAVE, lane, WSCALE); }
    }
#undef PG8_SA
#undef PG8_SB
#undef PG8_STAGE
#undef PG8_STAGEA
#undef PG8_LDA
#undef PG8_LDB
#undef PG8_MMA
#undef PG8_CAT
#undef PG8_WAIT_V
#undef PG8_WAIT_L
#undef PG8_BAR
#undef PG8_SCHED
#undef PG8_TOK2
#undef PG8_KBODY
}
}

#define XB_TMO      128
#define XB_XCNT(j)  (256  + 64 * (j))
#define XB_XSUB(j)  (1280 + 64 * (j))
#define XB_XGEN(j)  (2304 + 64 * (j))
#define XB_TOP      3328
#define XB_TOPGEN   3392
#define XCD_BAR_WORDS 3456
#define XB_SPIN_CAP (1u << 18)
__device__ __forceinline__ unsigned xb_ld(unsigned* p)              { return __hip_atomic_load(p, __ATOMIC_RELAXED, __HIP_MEMORY_SCOPE_AGENT); }
__device__ __forceinline__ unsigned xb_add(unsigned* p, unsigned v) { return __hip_atomic_fetch_add(p, v, __ATOMIC_RELAXED, __HIP_MEMORY_SCOPE_AGENT); }
__device__ __forceinline__ unsigned xb_xcc_id() { return (unsigned)__builtin_amdgcn_s_getreg((3 << 11) | 20) & 0xFu; }
#define XB_SPIN(cond, bar) do { unsigned _sp = 0; while (cond) { __builtin_amdgcn_s_sleep(1); \
    if ((++_sp & 255u) == 0u) { if (xb_ld(&(bar)[XB_TMO])) break; if (_sp > XB_SPIN_CAP) { atomicAdd(&(bar)[XB_TMO], 1u); break; } } } } while (0)
struct XcdBarrier { unsigned* bar; unsigned x; volatile LAS unsigned* st; };
__device__ __forceinline__ XcdBarrier xcd_barrier_post(unsigned* bar, volatile LAS unsigned* st) {
    XcdBarrier b; b.bar = bar; b.x = xb_xcc_id(); b.st = st;
    if (threadIdx.x == 0) (void)xb_add(&bar[XB_XCNT(b.x)], 1u);
    return b;
}
__device__ __forceinline__ void xcd_barrier_complete(unsigned* bar, unsigned x, unsigned& nloc, unsigned& nx) {
    const unsigned G = gridDim.x * gridDim.y * gridDim.z;
    unsigned sum, cnt, mine, sp = 0u;
    for (;;) {
        sum = 0u; cnt = 0u; mine = 0u;
#pragma unroll
        for (unsigned j = 0; j < 16; ++j) { const unsigned c = xb_ld(&bar[XB_XCNT(j)]); sum += c; cnt += (c > 0u) ? 1u : 0u; mine = (j == x) ? c : mine; }
        if (sum == G) break;
        __builtin_amdgcn_s_sleep(1);
        if ((++sp & 255u) == 0u) { if (xb_ld(&bar[XB_TMO])) break; if (sp > XB_SPIN_CAP) { atomicAdd(&bar[XB_TMO], 1u); break; } }
    }
    nloc = mine > 0u ? mine : 1u; nx = cnt > 0u ? cnt : 1u;
}
__device__ __forceinline__ void xcd_barrier(const XcdBarrier& b) {
    asm volatile("s_waitcnt vmcnt(0)" ::: "memory");
    __syncthreads();
    if (threadIdx.x == 0) {
        unsigned* bar = b.bar;
        __builtin_amdgcn_s_waitcnt(0);
        unsigned nloc = b.st[0], nx = b.st[1];
        if (nloc == 0u) { xcd_barrier_complete(bar, b.x, nloc, nx); b.st[0] = nloc; b.st[1] = nx; }
        const unsigned old = xb_add(&bar[XB_XSUB(b.x)], 1u);
        const unsigned gen = old / nloc;
        if (old + 1u == (gen + 1u) * nloc) {
            __builtin_amdgcn_fence(__ATOMIC_RELEASE, "agent");
            asm volatile("s_waitcnt vmcnt(0)" ::: "memory");
            const unsigned og = xb_add(&bar[XB_TOP], 1u);
            const unsigned tg = og / nx;
            if (og + 1u == (tg + 1u) * nx) xb_add(&bar[XB_TOPGEN], 1u);
            else XB_SPIN(xb_ld(&bar[XB_TOPGEN]) == tg, bar);
            __builtin_amdgcn_fence(__ATOMIC_ACQUIRE, "agent");
            xb_add(&bar[XB_XGEN(b.x)], 1u);
            asm volatile("s_waitcnt vmcnt(0)" ::: "memory");
        } else {
            XB_SPIN(xb_ld(&bar[XB_XGEN(b.x)]) == gen, bar);
            __builtin_amdgcn_fence(__ATOMIC_ACQUIRE, "agent");
            asm volatile("s_waitcnt vmcnt(0)" ::: "memory");
        }
    }
    __syncthreads();
}

constexpr int NWAVES = 8, NTHR = 512;
struct Args { const float* in[29]; float* out; unsigned char* ws; int ph_lo, ph_hi; };
static_assert(sizeof(Args) == 31 * 8 + 8, "Args has no padding");
enum { I_X = 0, I_MEM, I_GMIX, I_WIN, I_CONVW, I_CONVB, I_WA, I_BA, I_WX, I_BX, I_LAM, I_QN, I_KN, I_SINK, I_GMEM, I_WMKV, I_QNM, I_KNM, I_GOL, I_GOS, I_GOM, I_WOUT, I_GFFN, I_WR, I_BR, I_W1, I_B1, I_W2, I_B2 };

struct Frame {
    LAS unsigned char* lds;
    int tid, lane, wave, G, bid;
    float* out; unsigned char* ws;
};
struct InTab { const LAS unsigned* t;
    __device__ __forceinline__ const float* operator[](int i) const { const unsigned lo = __builtin_amdgcn_readfirstlane(t[2 * i]), hi = __builtin_amdgcn_readfirstlane(t[2 * i + 1]); return (const float*)(const GAS float*)(((unsigned long long)hi << 32) | lo); } };
__device__ __forceinline__ float wave_sum(float v) {
#pragma unroll
    for (int o = 1; o < 64; o <<= 1) v += __shfl_xor(v, o);
    return v;
}

template <int MODE>
__device__ __forceinline__ void p0_transpose_item(const float* W, int N, int Kp, const float* kscale, bf16* WT, LAS float* scr, int kb, int nb, int lane) {
    const int k0 = 64 * kb, n0 = 32 * nb;
    float v[32];
#pragma unroll
    for (int i = 0; i < 32; ++i) { const int kk = 2 * i + (lane >> 5); v[i] = W[(size_t)(k0 + kk) * N + n0 + (lane & 31)]; }
#pragma unroll
    for (int i = 0; i < 32; ++i) { const int kk = 2 * i + (lane >> 5); scr[kk * 33 + (lane & 31)] = kscale ? v[i] * kscale[k0 + kk] : v[i]; }
    LDS_WAIT(); asm volatile("" ::: "memory");
    const int c = lane & 7;
#pragma unroll
    for (int j = 0; j < 4; ++j) { const int n = (lane >> 3) + 8 * j; const LAS float* s = scr + (8 * c) * 33 + n;
        u32x4 o; o.x = pk2(s[0 * 33], s[1 * 33]); o.y = pk2(s[2 * 33], s[3 * 33]); o.z = pk2(s[4 * 33], s[5 * 33]); o.w = pk2(s[6 * 33], s[7 * 33]);
        int nn = n0 + n; if (MODE == 1) { const int a = nn >> 1, s1 = nn & 1; nn = 256 * (a >> 7) + 128 * s1 + (a & 127); }
        *(GAS u32x4*)(WT + (size_t)nn * Kp + k0 + 8 * c) = o; }
    LDS_WAIT(); asm volatile("" ::: "memory");
}
__device__ __forceinline__ void p0_prologue(Frame& F) {
    const InTab in{(const LAS unsigned*)(F.lds + PTAB_OFF)}; unsigned char* ws = F.ws;
    {
        LAS float* XN = (LAS float*)F.lds;
        LAS float* PART = (LAS float*)(F.lds + 32768);
        bf16* KM = (bf16*)(ws + SM_KM); bf16* VM = (bf16*)(ws + SM_VM); bf16* VMT = (bf16*)(ws + SM_VMT);
        for (int unit = F.bid; unit < 256; unit += F.G) {
            const int rg = unit >> 3, cs = unit & 7;
            __syncthreads();
            { const int m = 8 * rg + F.wave; const GAS f32x4* mr = (const GAS f32x4*)(in[I_MEM] + (size_t)m * D) + F.lane; f32x4 v[4]; float sq = 0.f;
#pragma unroll
              for (int j = 0; j < 4; ++j) { v[j] = mr[64 * j]; sq += (v[j].x * v[j].x + v[j].y * v[j].y) + (v[j].z * v[j].z + v[j].w * v[j].w); }
              const float rs = 1.0f / sqrtf(wave_sum(sq) * (1.0f / D) + EPS);
#pragma unroll
              for (int j = 0; j < 4; ++j) { const f32x4 g = *(const f32x4*)(in[I_GMEM] + 256 * j + 4 * F.lane); *(LAS f32x4*)(XN + F.wave * 1024 + 256 * j + 4 * F.lane) = v[j] * rs * g; } }
            __syncthreads();
            const int col = F.lane, kg = F.wave;
            float a[8];
#pragma unroll
            for (int r = 0; r < 8; ++r) a[r] = 0.f;
            const float* wp = in[I_WMKV] + (size_t)(128 * kg) * 512 + 64 * cs + col;
#pragma unroll 4
            for (int k = 0; k < 128; k += 4) {
                const float w0 = wp[(size_t)k * 512], w1 = wp[(size_t)(k + 1) * 512], w2 = wp[(size_t)(k + 2) * 512], w3 = wp[(size_t)(k + 3) * 512];
#pragma unroll
                for (int r = 0; r < 8; ++r) { const f32x4 x = *(const LAS f32x4*)(XN + r * 1024 + 128 * kg + k); a[r] += x.x * w0 + x.y * w1 + x.z * w2 + x.w * w3; }
            }
#pragma unroll
            for (int r = 0; r < 8; ++r) PART[(kg * 8 + r) * 64 + col] = a[r];
            __syncthreads();
            { const int r = F.wave, m = 8 * rg + r; float v = 0.f;
#pragma unroll
              for (int g = 0; g < 8; ++g) v += PART[(g * 8 + r) * 64 + col];
              if (cs < 4) { const float rk = 1.0f / sqrtf(wave_sum(v * v) * (1.0f / 64.0f) + EPS); KM[((size_t)cs * MEM_LEN + m) * 64 + col] = (bf16)f2bf(v * rk * in[I_KNM][col]); }
              else { const int h = cs - 4; VM[((size_t)h * MEM_LEN + m) * 64 + col] = (bf16)f2bf(v); const int kk = m & 31; VMT[((size_t)h * 64 + col) * MEM_LEN + (m & ~31) + 8 * ((kk >> 2) & 3) + 4 * (kk >> 4) + (kk & 3)] = (bf16)f2bf(v); } }
        }
        __syncthreads();
    }
    LAS float* scr = (LAS float*)(F.lds + F.wave * 16384);
    const int gw = F.bid * NWAVES + F.wave, NGW = F.G * NWAVES;
    constexpr int I_IN = 16 * 52, I_OUT = 16 * 32, I_W1E = 8 * 64, I_W2E = 8 * 32, I_LRU = 24;
    constexpr int NITEMS = I_IN + I_OUT + 32 * I_W1E + 32 * I_W2E + I_LRU;
    for (int it = gw; it < NITEMS - 32 * I_W1E - 32 * I_W2E; it += NGW) {
        int r = it;
        if (r < I_IN) { p0_transpose_item<0>(in[I_WIN], D_IN, D, in[I_GMIX], (bf16*)(ws + WS_WIN), scr, r / 52, r % 52, F.lane); continue; } r -= I_IN;
        if (r < I_OUT) { p0_transpose_item<0>(in[I_WOUT], D, D, nullptr, (bf16*)(ws + WS_WOUT), scr, r / 32, r % 32, F.lane); continue; } r -= I_OUT;
        { const int mat = r / 12, q = r % 12, h = q / 2, nb = q % 2;
          p0_transpose_item<0>(in[mat ? I_WX : I_WA] + (size_t)h * 4096, 64, 64, nullptr, (bf16*)(ws + (mat ? SM_WXT : SM_WAT)) + (size_t)h * 4096, scr, 0, nb, F.lane); }
    }
    const int gt = F.bid * NTHR + F.tid, NGT = F.G * NTHR;
    { u32x4* z = (u32x4*)((bf16*)(ws + WS_WIN) + (size_t)D_IN * D); for (int i = gt; i < (D_INP - D_IN) * D * 2 / 16; i += NGT) z[i] = (u32x4){0u, 0u, 0u, 0u}; }
    { float* b1p = (float*)(ws + SM_B1P); for (int i = gt; i < NE * FF2; i += NGT) { const int e = i / FF2, np = i % FF2; const int pn = np >> 8, s1 = (np >> 7) & 1, xx = np & 127; b1p[i] = in[I_B1][(size_t)e * FF2 + 2 * (128 * pn + xx) + s1]; } }
    { bf16* wrh = (bf16*)(ws + SM_WRH); bf16* wrl = (bf16*)(ws + SM_WRL);
      for (int i = gt; i < NE * D; i += NGT) { const int e = i >> 10, k = i & 1023; const float w = in[I_WR][(size_t)k * NE + e] * in[I_GFFN][k]; const unsigned hi = f2bf(w); wrh[i] = (bf16)hi; wrl[i] = (bf16)f2bf(w - __uint_as_float(hi << 16)); } }
    for (int m = 2 * gw; m < S; m += 2 * NGW) {
        const GAS f32x4* xr = (const GAS f32x4*)(in[I_X] + (size_t)m * D) + F.lane;
        f32x4 v[8]; float s2 = 0.f, s3 = 0.f;
#pragma unroll
        for (int j = 0; j < 8; ++j) v[j] = __builtin_nontemporal_load(xr + 64 * j);
#pragma unroll
        for (int j = 0; j < 4; ++j) { s2 += (v[j].x * v[j].x + v[j].y * v[j].y) + (v[j].z * v[j].z + v[j].w * v[j].w); s3 += (v[4 + j].x * v[4 + j].x + v[4 + j].y * v[4 + j].y) + (v[4 + j].z * v[4 + j].z + v[4 + j].w * v[4 + j].w); }
        s2 = wave_sum(s2); s3 = wave_sum(s3);
        if (F.lane == 0) { ((float*)(ws + SM_RSTD1))[m] = 1.0f / sqrtf(s2 * (1.0f / D) + EPS); ((float*)(ws + SM_RSTD1))[m + 1] = 1.0f / sqrtf(s3 * (1.0f / D) + EPS); }
        GAS unsigned long long* o8 = (GAS unsigned long long*)((bf16*)(ws + WS_XB) + (size_t)m * D) + F.lane;
#pragma unroll
        for (int j = 0; j < 8; ++j) o8[64 * j] = (unsigned long long)pk2(v[j].x, v[j].y) | ((unsigned long long)pk2(v[j].z, v[j].w) << 32);
    }
}

__device__ __forceinline__ float sigmoidf_(float x) { return __builtin_amdgcn_rcpf(1.0f + __builtin_amdgcn_exp2f(-1.4426950408889634f * x)); }
__device__ __forceinline__ float gelu_tanh(float x) { const float u = 0.7978845608028654f * (x + 0.044715f * x * x * x); return x * sigmoidf_(2.0f * u); }
__device__ __forceinline__ float rsq_(float x) { return __builtin_amdgcn_rsqf(x); }
__device__ __forceinline__ float sqrt_negexpm1(float x) { const float ser = -x * (1.0f + x * (0.5f + x * (0.16666667f + x * 0.041666668f))); const float dir = 1.0f - __builtin_amdgcn_exp2f(1.4426950408889634f * x);
    return __builtin_amdgcn_sqrtf(fmaxf(x > -0.125f ? ser : dir, 0.f)); }

__device__ __forceinline__ f32x4 mfma16(bf16x8 a, bf16x8 b, f32x4 c) { return __builtin_amdgcn_mfma_f32_16x16x32_bf16(a, b, c, 0, 0, 0); }
__device__ __forceinline__ bf16x8 frag_from(u32x4 w) { return __builtin_bit_cast(bf16x8, w); }
constexpr float LOG2E = 1.4426950408889634f;
__device__ __forceinline__ void q_frags(const bf16* U, int t, int col0, const float* gain, int g, bf16x8& q0, bf16x8& q1) {
    const bf16* qp = U + (size_t)t * D_INP + col0 + 8 * g;
    const u32x4 w0 = *(const u32x4*)qp, w1 = *(const u32x4*)(qp + 32);
    float f[16] = {bflo(w0.x), bfhi(w0.x), bflo(w0.y), bfhi(w0.y), bflo(w0.z), bfhi(w0.z), bflo(w0.w), bfhi(w0.w), bflo(w1.x), bfhi(w1.x), bflo(w1.y), bfhi(w1.y), bflo(w1.z), bfhi(w1.z), bflo(w1.w), bfhi(w1.w)};
    float sq = 0.f;
#pragma unroll
    for (int j = 0; j < 16; ++j) sq += f[j] * f[j];
    sq += __shfl_xor(sq, 16); sq += __shfl_xor(sq, 32);
    const float rs = 0.125f * LOG2E * rsq_(sq * (1.0f / 64.0f) + EPS);
    const f32x4 ga = *(const f32x4*)(gain + 8 * g), gb = *(const f32x4*)(gain + 8 * g + 4), gc = *(const f32x4*)(gain + 32 + 8 * g), gd = *(const f32x4*)(gain + 32 + 8 * g + 4);
    u32x4 o0, o1;
    o0.x = pk2(f[0] * rs * ga.x, f[1] * rs * ga.y); o0.y = pk2(f[2] * rs * ga.z, f[3] * rs * ga.w); o0.z = pk2(f[4] * rs * gb.x, f[5] * rs * gb.y); o0.w = pk2(f[6] * rs * gb.z, f[7] * rs * gb.w);
    o1.x = pk2(f[8] * rs * gc.x, f[9] * rs * gc.y); o1.y = pk2(f[10] * rs * gc.z, f[11] * rs * gc.w); o1.z = pk2(f[12] * rs * gd.x, f[13] * rs * gd.y); o1.w = pk2(f[14] * rs * gd.z, f[15] * rs * gd.w);
    q0 = frag_from(o0); q1 = frag_from(o1);
}

__device__ __forceinline__ void swa_tile_mfma(Frame& F, int b, pg8::W1Rider& R) {
    const InTab in{(const LAS unsigned*)(F.lds + PTAB_OFF)}; unsigned char* ws = F.ws;
    const bf16* U = (const bf16*)(ws + WS_U);
    constexpr int KP = 72, VP = 216;
    LAS bf16* Ks = (LAS bf16*)F.lds;
    LAS bf16* VT = Ks + 2 * 192 * KP;
    LAS float* SSQ = (LAS float*)(F.lds + 110592);
    const int t0 = 64 * b, g = F.lane >> 4, c16 = F.lane & 15;
    R.issue(F.lane);
    bf16x8 qf[3][2];
#pragma unroll
    for (int pi = 0; pi < 3; ++pi) { const int p = (F.tid >> 6) + 8 * pi, head = p >> 2, qt = p & 3; q_frags(U, t0 + 16 * qt + c16, OFF_Q + head * 64, in[I_QN], g, qf[pi][0], qf[pi][1]); }
    float sinkv[3];
#pragma unroll
    for (int pi = 0; pi < 3; ++pi) sinkv[pi] = in[I_SINK][((F.tid >> 6) + 8 * pi) >> 2];
    __syncthreads();
    {
        const int dg = F.tid & 7; u32x4 kvr[6], vvr[6];
#pragma unroll
        for (int i = 0; i < 6; ++i) { const int key = (F.tid >> 3) + 64 * (i % 3), kvh = i / 3, pos = t0 - 128 + key, pc = pos < 0 ? 0 : pos;
            kvr[i] = *(const u32x4*)(U + (size_t)pc * D_INP + OFF_K + kvh * 64 + dg * 8); vvr[i] = *(const u32x4*)(U + (size_t)pc * D_INP + OFF_V + kvh * 64 + dg * 8); }
        const f32x4 kn0 = *(const f32x4*)(in[I_KN] + dg * 8), kn1 = *(const f32x4*)(in[I_KN] + dg * 8 + 4);
#pragma unroll
        for (int i = 0; i < 6; ++i) { const int key = (F.tid >> 3) + 64 * (i % 3), kvh = i / 3, pos = t0 - 128 + key;
            u32x4 kv = kvr[i], vv = vvr[i]; if (pos < 0) { kv = (u32x4){0u, 0u, 0u, 0u}; vv = kv; }
            float f[8] = {bflo(kv.x), bfhi(kv.x), bflo(kv.y), bfhi(kv.y), bflo(kv.z), bfhi(kv.z), bflo(kv.w), bfhi(kv.w)};
            float sq = 0.f;
#pragma unroll
            for (int j = 0; j < 8; ++j) sq += f[j] * f[j];
            sq += __shfl_xor(sq, 1); sq += __shfl_xor(sq, 2); sq += __shfl_xor(sq, 4);
            const float rs = rsq_(sq * (1.0f / 64.0f) + EPS);
            u32x4 o; o.x = pk2(f[0] * rs * kn0.x, f[1] * rs * kn0.y); o.y = pk2(f[2] * rs * kn0.z, f[3] * rs * kn0.w); o.z = pk2(f[4] * rs * kn1.x, f[5] * rs * kn1.y); o.w = pk2(f[6] * rs * kn1.z, f[7] * rs * kn1.w);
            *(LAS u32x4*)(Ks + (kvh * 192 + key) * KP + dg * 8) = o;
            LAS bf16* vt = VT + (kvh * 64 + dg * 8) * VP + key;
            vt[0 * VP] = (bf16)(vv.x & 0xffffu); vt[1 * VP] = (bf16)(vv.x >> 16); vt[2 * VP] = (bf16)(vv.y & 0xffffu); vt[3 * VP] = (bf16)(vv.y >> 16);
            vt[4 * VP] = (bf16)(vv.z & 0xffffu); vt[5 * VP] = (bf16)(vv.z >> 16); vt[6 * VP] = (bf16)(vv.w & 0xffffu); vt[7 * VP] = (bf16)(vv.w >> 16); }
    }
    for (int it = F.tid; it < 2 * 64 * 24; it += NTHR) VT[(it / 24) * VP + 192 + (it % 24)] = (bf16)0;
    R.retire(F.lane);
    __syncthreads();
    f32x4 oacc[3][4];
#pragma unroll
    for (int pi = 0; pi < 3; ++pi) {
        const int p = (F.tid >> 6) + 8 * pi, head = p >> 2, qt = p & 3, kvh = head / 3;
        const bf16x8 q0 = qf[pi][0], q1 = qf[pi][1];
        f32x4 st[10];
#pragma unroll
        for (int i = 0; i < 9; ++i) { const LAS bf16* kr = Ks + (kvh * 192 + 16 * (qt + i) + c16) * KP + 8 * g;
            f32x4 a = (f32x4){0.f, 0.f, 0.f, 0.f}; a = mfma16(*(const LAS bf16x8*)kr, q0, a); a = mfma16(*(const LAS bf16x8*)(kr + 32), q1, a); st[i] = a; }
        const float sink = sinkv[pi] * LOG2E; float mx = sink;
#pragma unroll
        for (int i = 0; i < 9; ++i)
#pragma unroll
            for (int r = 0; r < 4; ++r) { const int koff = 4 * g + r; bool ok = (t0 - 128 + 16 * (qt + i) + koff) >= 0; if (i == 0) ok = ok && (koff > c16); if (i == 8) ok = ok && (koff <= c16);
                st[i][r] = ok ? st[i][r] : -1.0e30f; mx = fmaxf(mx, st[i][r]); }
        mx = fmaxf(mx, __shfl_xor(mx, 16)); mx = fmaxf(mx, __shfl_xor(mx, 32));
        float l = 0.f;
#pragma unroll
        for (int i = 0; i < 9; ++i)
#pragma unroll
            for (int r = 0; r < 4; ++r) { st[i][r] = __builtin_amdgcn_exp2f(st[i][r] - mx); l += st[i][r]; }
        st[9] = (f32x4){0.f, 0.f, 0.f, 0.f};
        l += __shfl_xor(l, 16); l += __shfl_xor(l, 32); l += __builtin_amdgcn_exp2f(sink - mx);
        f32x4 ot[4];
#pragma unroll
        for (int dt = 0; dt < 4; ++dt) ot[dt] = (f32x4){0.f, 0.f, 0.f, 0.f};
#pragma unroll
        for (int u = 0; u < 5; ++u) {
            u32x4 pw; pw.x = pk2(st[2 * u][0], st[2 * u][1]); pw.y = pk2(st[2 * u][2], st[2 * u][3]); pw.z = pk2(st[2 * u + 1][0], st[2 * u + 1][1]); pw.w = pk2(st[2 * u + 1][2], st[2 * u + 1][3]);
            const bf16x8 pf = frag_from(pw);
#pragma unroll
            for (int dt = 0; dt < 4; ++dt) { const LAS bf16* vr = VT + (kvh * 64 + 16 * dt + c16) * VP + 16 * (qt + 2 * u) + 4 * g;
                const u32x2 lo = *(const LAS u32x2*)vr, hi = *(const LAS u32x2*)(vr + 16);
                ot[dt] = mfma16(frag_from((u32x4){lo.x, lo.y, hi.x, hi.y}), pf, ot[dt]); }
        }
        const float il = __builtin_amdgcn_rcpf(l); float sq = 0.f;
#pragma unroll
        for (int dt = 0; dt < 4; ++dt) { oacc[pi][dt] = ot[dt] * il; sq += (oacc[pi][dt][0] * oacc[pi][dt][0] + oacc[pi][dt][1] * oacc[pi][dt][1]) + (oacc[pi][dt][2] * oacc[pi][dt][2] + oacc[pi][dt][3] * oacc[pi][dt][3]); }
        sq += __shfl_xor(sq, 16); sq += __shfl_xor(sq, 32);
        if (g == 0) SSQ[head * 64 + 16 * qt + c16] = sq;
    }
    R.issue(F.lane);
    f32x4 gsw[3][4];
#pragma unroll
    for (int pi = 0; pi < 3; ++pi)
#pragma unroll
        for (int dt = 0; dt < 4; ++dt) gsw[pi][dt] = *(const f32x4*)(in[I_GOS] + (((F.tid >> 6) + 8 * pi) >> 2) * 64 + 4 * g + 16 * dt);
    __syncthreads();
#pragma unroll
    for (int pi = 0; pi < 3; ++pi) {
        const int p = (F.tid >> 6) + 8 * pi, head = p >> 2, qt = p & 3; const int ql = 16 * qt + c16;
        const float tot = (SSQ[ql] + SSQ[64 + ql]) + (SSQ[128 + ql] + SSQ[192 + ql]) + (SSQ[256 + ql] + SSQ[320 + ql]);
        const float rs = rsq_(tot * (1.0f / 384.0f) + EPS);
        bf16* yo = (bf16*)(ws + WS_Y) + (size_t)(t0 + ql) * D + 384 + head * 64 + 4 * g;
#pragma unroll
        for (int dt = 0; dt < 4; ++dt) { const f32x4 gv = gsw[pi][dt]; const f32x4 o = oacc[pi][dt] * rs * gv; u32x2 w; w.x = pk2(o[0], o[1]); w.y = pk2(o[2], o[3]); *(u32x2*)(yo + 16 * dt) = w; }
    }
    R.retire(F.lane);
    __syncthreads();
}

__device__ __forceinline__ void mem_tile_mfma(Frame& F, int b, pg8::W1Rider& R) {
    const InTab in{(const LAS unsigned*)(F.lds + PTAB_OFF)}; unsigned char* ws = F.ws;
    const bf16* U = (const bf16*)(ws + WS_U);
    LAS unsigned char* KV = F.lds;
    LAS float* SSQ = (LAS float*)(F.lds + RING_BYTES + 5120);
    const int t0 = 64 * b, g = F.lane >> 4, c16 = F.lane & 15, head = F.tid >> 7, wq = (F.tid >> 6) & 1;
    R.issue(F.lane);
    bf16x8 q[2][2];
#pragma unroll
    for (int qi = 0; qi < 2; ++qi) q_frags(U, t0 + 16 * (2 * wq + qi) + c16, OFF_QM + head * 64, in[I_QNM], g, q[qi][0], q[qi][1]);
    __syncthreads();
    { const u32x4* src = (const u32x4*)(ws + SM_KM);
      u32x4 sv[16];
#pragma unroll
      for (int j = 0; j < 16; ++j) sv[j] = src[F.tid + 512 * j];
#pragma unroll
      for (int j = 0; j < 16; ++j) { const int idx = F.tid + 512 * j, c = idx & 7, row = idx >> 3; *(LAS u32x4*)(KV + (row * 8 + (c ^ (row & 7))) * 16) = sv[j]; } }
    R.retire(F.lane);
    __syncthreads();
    f32x4 st[2][16];
#pragma unroll
    for (int kt = 0; kt < 16; ++kt) { const int row = head * 256 + 16 * kt + c16;
        const bf16x8 k0 = *(const LAS bf16x8*)(KV + (row * 8 + (g ^ (row & 7))) * 16), k1 = *(const LAS bf16x8*)(KV + (row * 8 + ((4 + g) ^ (row & 7))) * 16);
#pragma unroll
        for (int qi = 0; qi < 2; ++qi) { f32x4 a = (f32x4){0.f, 0.f, 0.f, 0.f}; a = mfma16(k0, q[qi][0], a); a = mfma16(k1, q[qi][1], a); st[qi][kt] = a; } }
    u32x4 pf[2][8]; float il[2];
#pragma unroll
    for (int qi = 0; qi < 2; ++qi) { float mx = -1.0e30f;
#pragma unroll
        for (int kt = 0; kt < 16; ++kt) mx = fmaxf(fmaxf(mx, fmaxf(st[qi][kt][0], st[qi][kt][1])), fmaxf(st[qi][kt][2], st[qi][kt][3]));
        mx = fmaxf(mx, __shfl_xor(mx, 16)); mx = fmaxf(mx, __shfl_xor(mx, 32));
        float l = 0.f;
#pragma unroll
        for (int kt = 0; kt < 16; ++kt)
#pragma unroll
            for (int r = 0; r < 4; ++r) { st[qi][kt][r] = __builtin_amdgcn_exp2f(st[qi][kt][r] - mx); l += st[qi][kt][r]; }
        l += __shfl_xor(l, 16); l += __shfl_xor(l, 32); il[qi] = __builtin_amdgcn_rcpf(l);
#pragma unroll
        for (int u = 0; u < 8; ++u) { pf[qi][u].x = pk2(st[qi][2 * u][0], st[qi][2 * u][1]); pf[qi][u].y = pk2(st[qi][2 * u][2], st[qi][2 * u][3]); pf[qi][u].z = pk2(st[qi][2 * u + 1][0], st[qi][2 * u + 1][1]); pf[qi][u].w = pk2(st[qi][2 * u + 1][2], st[qi][2 * u + 1][3]); } }
    R.issue(F.lane);
    __syncthreads();
    { const u32x4* src = (const u32x4*)(ws + SM_VMT);
#pragma unroll 8
      for (int j = 0; j < 16; ++j) { const int idx = F.tid + 512 * j, c = idx & 31, row = idx >> 5; *(LAS u32x4*)(KV + (row * 32 + (c ^ (row & 7))) * 16) = src[idx]; } }
    R.retire(F.lane);
    __syncthreads();
    f32x4 ot[2][4];
#pragma unroll
    for (int qi = 0; qi < 2; ++qi)
#pragma unroll
        for (int dt = 0; dt < 4; ++dt) ot[qi][dt] = (f32x4){0.f, 0.f, 0.f, 0.f};
#pragma unroll
    for (int u = 0; u < 8; ++u)
#pragma unroll
        for (int dt = 0; dt < 4; ++dt) { const int row = head * 64 + 16 * dt + c16; const bf16x8 vf = *(const LAS bf16x8*)(KV + (row * 32 + ((4 * u + g) ^ (row & 7))) * 16);
            ot[0][dt] = mfma16(vf, frag_from(pf[0][u]), ot[0][dt]); ot[1][dt] = mfma16(vf, frag_from(pf[1][u]), ot[1][dt]); }
#pragma unroll
    for (int qi = 0; qi < 2; ++qi) { float sq = 0.f;
#pragma unroll
        for (int dt = 0; dt < 4; ++dt) { ot[qi][dt] *= il[qi]; sq += (ot[qi][dt][0] * ot[qi][dt][0] + ot[qi][dt][1] * ot[qi][dt][1]) + (ot[qi][dt][2] * ot[qi][dt][2] + ot[qi][dt][3] * ot[qi][dt][3]); }
        sq += __shfl_xor(sq, 16); sq += __shfl_xor(sq, 32);
        if (g == 0) SSQ[head * 64 + 16 * (2 * wq + qi) + c16] = sq; }
    R.issue(F.lane);
    f32x4 gmv[4];
#pragma unroll
    for (int dt = 0; dt < 4; ++dt) gmv[dt] = *(const f32x4*)(in[I_GOM] + head * 64 + 4 * g + 16 * dt);
    __syncthreads();
#pragma unroll
    for (int qi = 0; qi < 2; ++qi) {
        const int ql = 16 * (2 * wq + qi) + c16;
        const float tot = (SSQ[ql] + SSQ[64 + ql]) + (SSQ[128 + ql] + SSQ[192 + ql]);
        const float rs = rsq_(tot * (1.0f / 256.0f) + EPS);
        bf16* yo = (bf16*)(ws + WS_Y) + (size_t)(t0 + ql) * D + 768 + head * 64 + 4 * g;
#pragma unroll
        for (int dt = 0; dt < 4; ++dt) { const f32x4 gv = gmv[dt]; const f32x4 o = ot[qi][dt] * rs * gv; u32x2 w; w.x = pk2(o[0], o[1]); w.y = pk2(o[2], o[3]); *(u32x2*)(yo + 16 * dt) = w; }
    }
    R.retire(F.lane);
    __syncthreads();
}

__device__ __forceinline__ void lru_tile_mfma(Frame& F, int b, pg8::W1Rider& R) {
    const InTab in{(const LAS unsigned*)(F.lds + PTAB_OFF)}; unsigned char* ws = F.ws;
    const bf16* U = (const bf16*)(ws + WS_U);
    constexpr int UP = 72;
    LAS bf16* UL = (LAS bf16*)(F.lds + (F.tid >> 6) * 20480);
    LAS bf16* GL = UL + 68 * UP;
    float* AAGG = (float*)(ws + SM_AAGG); float* BAGG = (float*)(ws + SM_BAGG); unsigned* YP = (unsigned*)(ws + WS_YP);
    const int t0 = 64 * b, g = F.lane >> 4, c16 = F.lane & 15, hd = F.tid >> 6;
    __syncthreads();
    if (hd < 6) {
        {
            u32x4 uv[9], gv[8]; const int ch = F.lane & 7;
#pragma unroll
            for (int i = 0; i < 9; ++i) { const int row = min((F.lane >> 3) + 8 * i, 66), t = t0 - 3 + row; uv[i] = *(const u32x4*)(U + (size_t)(t < 0 ? 0 : t) * D_INP + OFF_LRU + hd * 64 + 8 * ch); }
#pragma unroll
            for (int i = 0; i < 8; ++i) { const int row = (F.lane >> 3) + 8 * i; gv[i] = *(const u32x4*)(U + (size_t)(t0 + row) * D_INP + OFF_GATE + hd * 64 + 8 * ch); }
#pragma unroll
            for (int i = 0; i < 9; ++i) { const int row = (F.lane >> 3) + 8 * i, t = t0 - 3 + row; u32x4 v = uv[i]; if (t < 0) v = (u32x4){0u, 0u, 0u, 0u};
                if (row < 67) *(LAS u32x4*)(UL + row * UP + 8 * ch) = v; }
#pragma unroll
            for (int i = 0; i < 8; ++i) { const int row = (F.lane >> 3) + 8 * i; *(LAS u32x4*)(GL + row * UP + 8 * ch) = gv[i]; }
        }
        LDS_WAIT(); asm volatile("" ::: "memory");
        bf16x8 xa[4][2];
#pragma unroll
        for (int s = 0; s < 2; ++s) {
            const int cbase = hd * 64 + 32 * s + 8 * g;
            float cw[4][8], cbv[8];
#pragma unroll
            for (int k = 0; k < 4; ++k) { const f32x4 a = *(const f32x4*)(in[I_CONVW] + k * 384 + cbase), bq = *(const f32x4*)(in[I_CONVW] + k * 384 + cbase + 4);
                cw[k][0] = a.x; cw[k][1] = a.y; cw[k][2] = a.z; cw[k][3] = a.w; cw[k][4] = bq.x; cw[k][5] = bq.y; cw[k][6] = bq.z; cw[k][7] = bq.w; }
            { const f32x4 a = *(const f32x4*)(in[I_CONVB] + cbase), bq = *(const f32x4*)(in[I_CONVB] + cbase + 4); cbv[0] = a.x; cbv[1] = a.y; cbv[2] = a.z; cbv[3] = a.w; cbv[4] = bq.x; cbv[5] = bq.y; cbv[6] = bq.z; cbv[7] = bq.w; }
#pragma unroll
            for (int tt = 0; tt < 4; ++tt) {
                float xv[8];
#pragma unroll
                for (int j = 0; j < 8; ++j) xv[j] = cbv[j];
#pragma unroll
                for (int k = 0; k < 4; ++k) { const u32x4 w = *(const LAS u32x4*)(UL + (16 * tt + c16 + k) * UP + 32 * s + 8 * g);
                    xv[0] += cw[k][0] * bflo(w.x); xv[1] += cw[k][1] * bfhi(w.x); xv[2] += cw[k][2] * bflo(w.y); xv[3] += cw[k][3] * bfhi(w.y);
                    xv[4] += cw[k][4] * bflo(w.z); xv[5] += cw[k][5] * bfhi(w.z); xv[6] += cw[k][6] * bflo(w.w); xv[7] += cw[k][7] * bfhi(w.w); }
                xa[tt][s] = frag_from((u32x4){pk2(xv[0], xv[1]), pk2(xv[2], xv[3]), pk2(xv[4], xv[5]), pk2(xv[6], xv[7])});
            }
        }
        const bf16* WaT = (const bf16*)(ws + SM_WAT) + (size_t)hd * 4096; const bf16* WxT = (const bf16*)(ws + SM_WXT) + (size_t)hd * 4096;
        bf16x8 wan[2], wxn[2];
#pragma unroll
        for (int s = 0; s < 2; ++s) { wan[s] = *(const bf16x8*)(WaT + c16 * 64 + 32 * s + 8 * g); wxn[s] = *(const bf16x8*)(WxT + c16 * 64 + 32 * s + 8 * g); }
        float lamv[4], bav[4], bxv[4];
#pragma unroll
        for (int ct = 0; ct < 4; ++ct) { const int c = hd * 64 + 16 * ct + c16; lamv[ct] = in[I_LAM][c]; bav[ct] = in[I_BA][c]; bxv[ct] = in[I_BX][c]; }
#pragma unroll 1
        for (int ct = 0; ct < 4; ++ct) {
            const int cp = 16 * ct + c16, c = hd * 64 + cp;
            const float lam_c = ct == 0 ? lamv[0] : ct == 1 ? lamv[1] : ct == 2 ? lamv[2] : lamv[3], ba = ct == 0 ? bav[0] : ct == 1 ? bav[1] : ct == 2 ? bav[2] : bav[3], bxb = ct == 0 ? bxv[0] : ct == 1 ? bxv[1] : ct == 2 ? bxv[2] : bxv[3];
            bf16x8 waf[2], wxf[2], idf[2];
#pragma unroll
            for (int s = 0; s < 2; ++s) { waf[s] = wan[s]; wxf[s] = wxn[s]; const int cpn = 16 * ((ct + 1) & 3) + c16; wan[s] = *(const bf16x8*)(WaT + cpn * 64 + 32 * s + 8 * g); wxn[s] = *(const bf16x8*)(WxT + cpn * 64 + 32 * s + 8 * g);
                u32x4 iw; const int kb = 32 * s + 8 * g;
                iw.x = (kb + 0 == cp ? 0x3F80u : 0u) | (kb + 1 == cp ? 0x3F800000u : 0u); iw.y = (kb + 2 == cp ? 0x3F80u : 0u) | (kb + 3 == cp ? 0x3F800000u : 0u);
                iw.z = (kb + 4 == cp ? 0x3F80u : 0u) | (kb + 5 == cp ? 0x3F800000u : 0u); iw.w = (kb + 6 == cp ? 0x3F80u : 0u) | (kb + 7 == cp ? 0x3F800000u : 0u); idf[s] = frag_from(iw); }
            f32x4 Da[4], Dx[4], Dc[4], yv[4];
#pragma unroll
            for (int tt = 0; tt < 4; ++tt) { f32x4 z = (f32x4){0.f, 0.f, 0.f, 0.f};
                Da[tt] = mfma16(xa[tt][1], waf[1], mfma16(xa[tt][0], waf[0], z)); Dx[tt] = mfma16(xa[tt][1], wxf[1], mfma16(xa[tt][0], wxf[0], z)); Dc[tt] = mfma16(xa[tt][1], idf[1], mfma16(xa[tt][0], idf[0], z));
                const f32x4 dg = mfma16(*(const LAS bf16x8*)(GL + (16 * tt + c16) * UP + 32 + 8 * g), idf[1], mfma16(*(const LAS bf16x8*)(GL + (16 * tt + c16) * UP + 8 * g), idf[0], z));
#pragma unroll
                for (int r = 0; r < 4; ++r) yv[tt][r] = gelu_tanh(dg[r]); }
            const float sp = log1pf(__expf(-lam_c));
#pragma unroll
            for (int tt = 0; tt < 4; ++tt)
#pragma unroll
                for (int r = 0; r < 4; ++r) { const float rr = sigmoidf_(Da[tt][r] + ba), ig = sigmoidf_(Dx[tt][r] + bxb); const float la = -8.0f * rr * sp;
                    Da[tt][r] = __builtin_amdgcn_exp2f(LOG2E * la); Dx[tt][r] = sqrt_negexpm1(2.0f * la) * ig * Dc[tt][r]; }
            float hs = 0.f, Atot = 1.f;
#pragma unroll
            for (int tt = 0; tt < 4; ++tt) {
                const f32x4 a = Da[tt], bb = Dx[tt];
                float Ai = (a[0] * a[1]) * (a[2] * a[3]), Bi = ((bb[0] * a[1] + bb[1]) * a[2] + bb[2]) * a[3] + bb[3];
                float Ap = __shfl_up(Ai, 16), Bp = __shfl_up(Bi, 16); if (g >= 1) { Bi = Ai * Bp + Bi; Ai = Ap * Ai; }
                Ap = __shfl_up(Ai, 32); Bp = __shfl_up(Bi, 32); if (g >= 2) { Bi = Ai * Bp + Bi; Ai = Ap * Ai; }
                float Ae = __shfl_up(Ai, 16), Be = __shfl_up(Bi, 16); if (g == 0) { Ae = 1.f; Be = 0.f; }
                float hl = Ae * hs + Be, pl = Atot * Ae;
#pragma unroll
                for (int r = 0; r < 4; ++r) { hl = a[r] * hl + bb[r]; pl *= a[r];
                    YP[(size_t)(t0 + 16 * tt + 4 * g + r) * 384 + c] = pk2(hl * yv[tt][r], pl * yv[tt][r]); }
                const float A3 = __shfl(Ai, c16 + 48), B3 = __shfl(Bi, c16 + 48); hs = A3 * hs + B3; Atot *= A3;
            }
            if (g == 0) { AAGG[(size_t)c * NTILE + b] = Atot; BAGG[(size_t)c * NTILE + b] = hs; }
            }
    }
    __syncthreads();
}

__device__ __forceinline__ void lru_fix_tile(Frame& F, int b, pg8::W1Rider& R) {
    const InTab in{(const LAS unsigned*)(F.lds + PTAB_OFF)}; unsigned char* ws = F.ws;
    LAS float* CR = (LAS float*)F.lds;
    const int t0 = 64 * b;
    R.issue(F.lane);
    __syncthreads();
    if (F.tid < 384) CR[F.tid] = ((const float*)(ws + SM_CARRY))[(size_t)F.tid * NTILE + b];
    __syncthreads();
    const int t = F.tid >> 3, part = F.tid & 7;
    const u32x4* yp = (const u32x4*)((const unsigned*)(ws + WS_YP) + (size_t)(t0 + t) * 384 + part * 48);
    float y[48]; float sq = 0.f;
#pragma unroll
    for (int j = 0; j < 12; ++j) { const u32x4 w = yp[j]; const f32x4 cr = *(const LAS f32x4*)(CR + part * 48 + 4 * j);
        y[4 * j] = bflo(w.x) + bfhi(w.x) * cr.x; y[4 * j + 1] = bflo(w.y) + bfhi(w.y) * cr.y; y[4 * j + 2] = bflo(w.z) + bfhi(w.z) * cr.z; y[4 * j + 3] = bflo(w.w) + bfhi(w.w) * cr.w;
        sq += (y[4 * j] * y[4 * j] + y[4 * j + 1] * y[4 * j + 1]) + (y[4 * j + 2] * y[4 * j + 2] + y[4 * j + 3] * y[4 * j + 3]); }
    sq += __shfl_xor(sq, 1); sq += __shfl_xor(sq, 2); sq += __shfl_xor(sq, 4);
    const float rs = rsq_(sq * (1.0f / 384.0f) + EPS);
    const float* gp = in[I_GOL] + part * 48; bf16* yo = (bf16*)(ws + WS_Y) + (size_t)(t0 + t) * D + part * 48;
    f32x4 gl[12];
#pragma unroll
    for (int j = 0; j < 12; ++j) gl[j] = *(const f32x4*)(gp + 4 * j);
#pragma unroll
    for (int j = 0; j < 6; ++j) { const f32x4 ga = gl[2 * j], gb = gl[2 * j + 1];
        u32x4 w; w.x = pk2(y[8 * j] * rs * ga.x, y[8 * j + 1] * rs * ga.y); w.y = pk2(y[8 * j + 2] * rs * ga.z, y[8 * j + 3] * rs * ga.w); w.z = pk2(y[8 * j + 4] * rs * gb.x, y[8 * j + 5] * rs * gb.y); w.w = pk2(y[8 * j + 6] * rs * gb.z, y[8 * j + 7] * rs * gb.w);
        *(u32x4*)(yo + 8 * j) = w; }
    R.retire(F.lane);
    __syncthreads();
}

__device__ __forceinline__ void moe_tables(Frame& F) {
    LAS int* cnt = (LAS int*)(F.lds + TAB_OFF); LAS int* tile_start = cnt + 32; LAS int* row_start = tile_start + 33; LAS int* mt_expert = row_start + 32;
    gu32* ctl = (gu32*)(F.ws + WS_CTL);
    __syncthreads();
    if (F.tid < 32) {
        const int e = F.tid, c = (int)__hip_atomic_load((unsigned*)(ctl + CW_CNT + 64 * e), RLX_AGENT), n = (c + 255) >> 8;
        int incl = n;
#pragma unroll
        for (int d = 1; d < 32; d <<= 1) { const int t = __shfl_up(incl, d); if (e >= d) incl += t; }
        const int ts = min(incl - n, MAXMT);
        cnt[e] = c; tile_start[e] = ts; row_start[e] = ts * 256;
        for (int j = 0; j < n && ts + j < MAXMT; ++j) mt_expert[ts + j] = e;
        if (e == 31) tile_start[32] = min(incl, MAXMT);
    }
    __syncthreads();
}


__device__ __forceinline__ void carry_scan(Frame& F) {
    unsigned char* ws = F.ws;
    const float* AAGG = (const float*)(ws + SM_AAGG); const float* BAGG = (const float*)(ws + SM_BAGG); float* CARRY = (float*)(ws + SM_CARRY);
    for (int c = F.wave * F.G + F.bid; c < 384; c += 8 * F.G) {
        const f32x4 a4 = *(const f32x4*)(AAGG + (size_t)c * NTILE + 4 * F.lane), b4 = *(const f32x4*)(BAGG + (size_t)c * NTILE + 4 * F.lane);
        float A = (a4[0] * a4[1]) * (a4[2] * a4[3]), B = ((b4[0] * a4[1] + b4[1]) * a4[2] + b4[2]) * a4[3] + b4[3];
#pragma unroll
        for (int d = 1; d < 64; d <<= 1) { const float Ap = __shfl_up(A, d), Bp = __shfl_up(B, d); if (F.lane >= d) { B = A * Bp + B; A = A * Ap; } }
        float h = __shfl_up(B, 1); if (F.lane == 0) h = 0.f;
        f32x4 o; o[0] = h; h = a4[0] * h + b4[0]; o[1] = h; h = a4[1] * h + b4[1]; o[2] = h; h = a4[2] * h + b4[2]; o[3] = h;
        *(f32x4*)(CARRY + (size_t)c * NTILE + 4 * F.lane) = o;
    }
}

__device__ __forceinline__ void router_tile_mfma(Frame& F, int b, pg8::W1Rider& R) {
    const InTab in{(const LAS unsigned*)(F.lds + PTAB_OFF)}; unsigned char* ws = F.ws;
    const bf16* H = (const bf16*)(ws + WS_HBF);
    LAS float* LOGP = (LAS float*)F.lds;
    LAS float* RS = (LAS float*)(F.lds + 2 * 64 * 33 * 4);
    LAS int* hist = (LAS int*)(RS + 64);
    LAS int* base = hist + 32;
    gu32* ctl = (gu32*)(ws + WS_CTL);
    const int t0 = 64 * b, g = F.lane >> 4, c16 = F.lane & 15, tt = F.wave & 3, kh = F.wave >> 2;
    __syncthreads();
    if (F.tid < 64) { const float* sp = (const float*)(ws + SM_SSQP) + (size_t)(t0 + F.tid) * 16; float s = 0.f;
#pragma unroll
        for (int j = 0; j < 4; ++j) { const f32x4 v = *(const f32x4*)(sp + 4 * j); s += (v.x + v.y) + (v.z + v.w); }
        const float r = rsq_(s * (1.0f / D) + EPS); RS[F.tid] = r; ((float*)(ws + SM_RSTD2))[t0 + F.tid] = r; }
    if (F.tid < 32) hist[F.tid] = 0;
    R.issue(F.lane);
    const f32x4 brv = *(const f32x4*)(in[I_BR] + 4 * (F.lane & 7));
    f32x4 acc0 = (f32x4){0.f, 0.f, 0.f, 0.f}, acc1 = acc0;
    const bf16* hp = H + (size_t)(t0 + 16 * tt + c16) * D + 512 * kh + 8 * g;
    const bf16* wh = (const bf16*)(ws + SM_WRH) + (size_t)c16 * D + 512 * kh + 8 * g; const bf16* wl = (const bf16*)(ws + SM_WRL) + (size_t)c16 * D + 512 * kh + 8 * g;
#pragma unroll 4
    for (int ks = 0; ks < 16; ++ks) {
        const bf16x8 ahi = *(const bf16x8*)(hp + 32 * ks);
        const bf16x8 wh0 = *(const bf16x8*)(wh + 32 * ks), wh1 = *(const bf16x8*)(wh + 16 * D + 32 * ks), wl0 = *(const bf16x8*)(wl + 32 * ks), wl1 = *(const bf16x8*)(wl + 16 * D + 32 * ks);
        acc0 = mfma16(ahi, wh0, acc0); acc0 = mfma16(ahi, wl0, acc0);
        acc1 = mfma16(ahi, wh1, acc1); acc1 = mfma16(ahi, wl1, acc1);
    }
    R.retire(F.lane);
#pragma unroll
    for (int r = 0; r < 4; ++r) { LOGP[(kh * 64 + 16 * tt + 4 * g + r) * 33 + c16] = acc0[r]; LOGP[(kh * 64 + 16 * tt + 4 * g + r) * 33 + 16 + c16] = acc1[r]; }
    __syncthreads();
    const int s8 = F.lane & 7, tk = 8 * F.wave + (F.lane >> 3);
    float v[4]; int es[4]; float vs[4];
    { const LAS float* l0 = LOGP + tk * 33 + 4 * s8; const LAS float* l1 = l0 + 64 * 33; const float rs = RS[tk];
#pragma unroll
        for (int i = 0; i < 4; ++i) v[i] = (l0[i] + l1[i]) * rs + brv[i]; }
#pragma unroll
    for (int k = 0; k < 4; ++k) {
        float bv = v[0]; int gi = 4 * s8;
#pragma unroll
        for (int i = 1; i < 4; ++i) if (v[i] > bv) { bv = v[i]; gi = 4 * s8 + i; }
#pragma unroll
        for (int d = 1; d < 8; d <<= 1) { const float ov = __shfl_xor(bv, d); const int oi = __shfl_xor(gi, d); if (ov > bv || (ov == bv && oi < gi)) { bv = ov; gi = oi; } }
        vs[k] = bv; es[k] = gi;
#pragma unroll
        for (int i = 0; i < 4; ++i) if (gi == 4 * s8 + i) v[i] = -3.4e38f;
    }
    float gs[4]; { float sum = 0.f;
#pragma unroll
        for (int k = 0; k < 4; ++k) { gs[k] = __expf(vs[k] - vs[0]); sum += gs[k]; }
        const float inv = 1.0f / sum;
#pragma unroll
        for (int k = 0; k < 4; ++k) gs[k] *= inv; }
    const int my_e = s8 == 0 ? es[0] : s8 == 1 ? es[1] : s8 == 2 ? es[2] : es[3]; const float my_g = s8 == 0 ? gs[0] : s8 == 1 ? gs[1] : s8 == 2 ? gs[2] : gs[3];
    int lp = 0;
    if (s8 < 4) lp = atomicAdd((int*)&hist[my_e], 1);
    R.issue(F.lane);
    __syncthreads();
    if (F.tid < 32) { const int hcount = hist[F.tid]; base[F.tid] = hcount ? (int)__hip_atomic_fetch_add((unsigned*)(ctl + CW_CNT + 64 * F.tid), (unsigned)hcount, RLX_AGENT) : 0; }
    __syncthreads();
    if (s8 < 4) {
        const int t = t0 + tk; unsigned* list = (unsigned*)(ws + SM_LIST); float* rsl = (float*)(ws + SM_RSLIST);
        unsigned* ts = (unsigned*)(ws + SM_TOKSLOT); float* gt = (float*)(ws + SM_GATE);
        const int pos = base[my_e] + lp; list[(size_t)my_e * CAP + pos] = (unsigned)t; rsl[(size_t)my_e * CAP + pos] = RS[tk];
        ts[t * 4 + s8] = ((unsigned)my_e << 16) | (unsigned)pos; gt[t * 4 + s8] = my_g;
    }
    R.retire(F.lane);
    __syncthreads();
}

__device__ __forceinline__ f32x4 fp8x4_to_f32(unsigned w) { const f32x2 lo = __builtin_amdgcn_cvt_pk_f32_fp8((int)w, false), hi = __builtin_amdgcn_cvt_pk_f32_fp8((int)w, true); return (f32x4){lo.x, lo.y, hi.x, hi.y}; }
__device__ __forceinline__ void combine_tile2(Frame& F, int b) {
    unsigned char* ws = F.ws;
    const LAS int* row_start = (const LAS int*)(F.lds + TAB_OFF) + 32 + 33;
    const unsigned* ts = (const unsigned*)(ws + SM_TOKSLOT); const float* gt = (const float*)(ws + SM_GATE); const unsigned char* Y2 = ws + WS_Y2;
    const int tw = 64 * b + 8 * F.wave;
    const u32x4 sl = *(const u32x4*)(ts + (tw + (F.lane & 7)) * 4); const f32x4 gl = *(const f32x4*)(gt + (tw + (F.lane & 7)) * 4) * (1.0f / YSCALE);
    const int r0 = row_start[sl.x >> 16] + (int)(sl.x & 0xffffu), r1 = row_start[sl.y >> 16] + (int)(sl.y & 0xffffu), r2 = row_start[sl.z >> 16] + (int)(sl.z & 0xffffu), r3 = row_start[sl.w >> 16] + (int)(sl.w & 0xffffu);
#pragma unroll
    for (int bt = 0; bt < 2; ++bt) {
        unsigned yv[4][4][4]; u32x2 hv[4][4];
#pragma unroll
        for (int i = 0; i < 4; ++i) { const int k = 4 * bt + i;
            const unsigned char* y0 = Y2 + (size_t)__builtin_amdgcn_readlane(r0, k) * D + 4 * F.lane; const unsigned char* y1 = Y2 + (size_t)__builtin_amdgcn_readlane(r1, k) * D + 4 * F.lane;
            const unsigned char* y2 = Y2 + (size_t)__builtin_amdgcn_readlane(r2, k) * D + 4 * F.lane; const unsigned char* y3 = Y2 + (size_t)__builtin_amdgcn_readlane(r3, k) * D + 4 * F.lane;
            const bf16* hq = (const bf16*)(ws + WS_HBF) + (size_t)(tw + k) * D + 4 * F.lane;
#pragma unroll
            for (int j = 0; j < 4; ++j) { yv[i][0][j] = __builtin_nontemporal_load((const unsigned*)(y0 + 256 * j)); yv[i][1][j] = __builtin_nontemporal_load((const unsigned*)(y1 + 256 * j));
                yv[i][2][j] = __builtin_nontemporal_load((const unsigned*)(y2 + 256 * j)); yv[i][3][j] = __builtin_nontemporal_load((const unsigned*)(y3 + 256 * j));
                hv[i][j] = __builtin_nontemporal_load((const u32x2*)(hq + 256 * j)); } }
#pragma unroll
        for (int i = 0; i < 4; ++i) { const int k = 4 * bt + i;
            const float g0 = __uint_as_float(__builtin_amdgcn_readlane(__float_as_uint(gl.x), k)), g1 = __uint_as_float(__builtin_amdgcn_readlane(__float_as_uint(gl.y), k));
            const float g2 = __uint_as_float(__builtin_amdgcn_readlane(__float_as_uint(gl.z), k)), g3 = __uint_as_float(__builtin_amdgcn_readlane(__float_as_uint(gl.w), k));
            float* op = F.out + (size_t)(tw + k) * D + 4 * F.lane;
#pragma unroll
            for (int j = 0; j < 4; ++j) { f32x4 o = (f32x4){bflo(hv[i][j].x), bfhi(hv[i][j].x), bflo(hv[i][j].y), bfhi(hv[i][j].y)};
                o += fp8x4_to_f32(yv[i][0][j]) * g0 + fp8x4_to_f32(yv[i][1][j]) * g1 + fp8x4_to_f32(yv[i][2][j]) * g2 + fp8x4_to_f32(yv[i][3][j]) * g3;
                *(f32x4*)(op + 256 * j) = o; } }
    }
}

constexpr int N_LAUNCHES = MK_N_LAUNCHES, PER_PHASE = 10, P1X_K = 8;
__global__ void __launch_bounds__(NTHR, 2) hymba_fwd(Args args) {
    extern __shared__ __attribute__((aligned(16))) unsigned char lds[];
    Frame F;
    F.lds = (LAS unsigned char*)lds;
    F.tid = threadIdx.x; F.lane = F.tid & 63; F.wave = __builtin_amdgcn_readfirstlane(F.tid >> 6);
    F.G = gridDim.x; F.bid = blockIdx.x; F.out = args.out; F.ws = args.ws;
    unsigned char* ws = args.ws;
    gu32* ctl = (gu32*)(ws + WS_CTL);
    for (int u = F.tid; u < (LDS_BYTES - LDSCTL_OFF) / 4; u += NTHR) ((LAS unsigned*)(F.lds + LDSCTL_OFF))[u] = 0u;
    __syncthreads();
    if (F.tid == 0) { LAS unsigned long long* pt = (LAS unsigned long long*)(F.lds + PTAB_OFF);
#pragma unroll
        for (int i = 0; i < 29; ++i) pt[i] = (unsigned long long)args.in[i]; }
    __syncthreads();
    const InTab in{(const LAS unsigned*)(F.lds + PTAB_OFF)};
    XcdBarrier bar; bar.bar = (unsigned*)(ctl + CW_BAR); bar.x = 0; bar.st = nullptr;
    if (N_LAUNCHES != PER_PHASE) bar = xcd_barrier_post((unsigned*)(ctl + CW_BAR), (volatile LAS unsigned*)(F.lds + MISC_OFF) + 8);
#define GRID_BAR(seam) do { if (N_LAUNCHES == PER_PHASE) { if (F.tid == 0) __hip_atomic_store(ctl + CW_TMO, 0xBADBA0u | (unsigned)(seam), RLX_AGENT); } else { xcd_barrier(bar); } } while (0)
    const int lo = args.ph_lo, hi = args.ph_hi;
#ifndef PH_MASK
#define PH_MASK 0x3ff
#endif
#define IN(k) (((PH_MASK >> (k)) & 1) && lo <= (k) && (k) < hi)
#define BOTH(k) (IN(k) && IN((k) + 1))
    LAS int* tab = (LAS int*)(F.lds + TAB_OFF);
#define REFRAME() do { int _t = threadIdx.x; asm volatile("" : "+v"(_t)); F.tid = _t; F.lane = _t & 63; F.wave = __builtin_amdgcn_readfirstlane(_t >> 6); } while (0)

    const int p1_units = (S / 256) * (D_INP / 256), p1_first_spare = p1_units - ((p1_units - 1) / F.G) * F.G, p1_spare = p1_first_spare < F.G ? F.G - p1_first_spare : 0;
    const int p1x = (p1_spare * NWAVES * P1X_K <= pg8::W1_PASSES / 2) ? p1_spare * NWAVES * P1X_K : 0, px0 = pg8::W1_PASSES - p1x;
    if (IN(0)) { REFRAME(); p0_prologue(F); if (BOTH(0)) GRID_BAR(0); }
    if (IN(1)) { REFRAME();
        pg8::SchedDense Sd; Sd.init(S, D_INP, F.G, F.bid, (const bf16*)(ws + WS_WIN));
        pg8::EpiInProj E{(bf16*)(ws + WS_U), (const float*)(ws + SM_RSTD1)};
        pg8::gemm_phase(F.lds, (const bf16*)(ws + WS_XB), (unsigned)S * D * 2u, Sd, E);
        if (p1x > 0 && F.bid >= p1_first_spare) { REFRAME(); pg8::W1Rider R; R.init_x(in[I_W1], ws + WS_W1, F.lds, F.wave, px0 + (F.bid - p1_first_spare) * NWAVES + F.wave, p1_spare * NWAVES, pg8::W1_PASSES); R.drain3(F.lane); }
        if (BOTH(1)) GRID_BAR(1);
    }
    if (IN(2)) { REFRAME();
        { pg8::W1Rider R0; R0.qlive = -1; for (int b = F.bid; b < NTILE; b += F.G) { REFRAME(); lru_tile_mfma(F, b, R0); } }
        REFRAME();
        pg8::W1Rider R; R.init(in[I_W1], ws + WS_W1, F.lds, F.bid * NWAVES + F.wave, F.G * NWAVES, F.wave, 0, 5, px0);
        for (int b = F.bid; b < NTILE; b += F.G) { REFRAME(); swa_tile_mfma(F, b, R); }
        for (int b = F.bid; b < NTILE; b += F.G) { REFRAME(); mem_tile_mfma(F, b, R); }
        REFRAME(); R.drain(F.lane);
        if (BOTH(2)) GRID_BAR(2);
    }
    if (IN(3)) { REFRAME(); carry_scan(F); if (BOTH(3)) GRID_BAR(3); }
    if (IN(4)) { REFRAME();
        pg8::W1Rider R; R.init(in[I_W1], ws + WS_W1, F.lds, F.bid * NWAVES + F.wave, F.G * NWAVES, F.wave, 5, 7, px0);
        for (int b = F.bid; b < NTILE; b += F.G) { REFRAME(); lru_fix_tile(F, b, R); }
        REFRAME(); R.drain(F.lane);
        if (BOTH(4)) GRID_BAR(4);
    }
    if (IN(5)) { REFRAME();
        pg8::SchedDense Sd; Sd.init(S, D, F.G, F.bid, (const bf16*)(ws + WS_WOUT));
        pg8::EpiOutProj E{in[I_X], (bf16*)(ws + WS_HBF), ws + WS_HB, (float*)(ws + SM_SSQP), in[I_GFFN]};
        pg8::gemm_phase(F.lds, (const bf16*)(ws + WS_Y), (unsigned)S * D * 2u, Sd, E);
        if (BOTH(5)) GRID_BAR(5);
    }
    if (IN(6)) { REFRAME();
        pg8::W1Rider R; R.init(in[I_W1], ws + WS_W1, F.lds, F.bid * NWAVES + F.wave, F.G * NWAVES, F.wave, 7, 1 << 20, px0);
        for (int b = F.bid; b < NTILE; b += F.G) { REFRAME(); router_tile_mfma(F, b, R); }
        REFRAME(); R.drain3(F.lane);
        if (BOTH(6)) GRID_BAR(6);
    }
    if (IN(7)) { REFRAME();
        moe_tables(F);
        pg8::SchedMoE<true> Sm; Sm.NT = 8; Sm.G = F.G; Sm.c = F.bid; Sm.ntot = tab[32 + 32] * 8; Sm.Bt = (const bf16*)(ws + WS_W1); Sm.estride = (unsigned)FF2 * P8; Sm.Bbytes = 32u * FF2 * P8;
        Sm.cnt = tab; Sm.tile_start = tab + 32; Sm.row_start = tab + 65; Sm.mt_expert = tab + 97; Sm.list = (const unsigned*)(ws + SM_LIST);
        pg8::EpiMoE1 E{in[I_W2], ws + WS_W2, ws + WS_ACT, (const float*)(ws + SM_B1P), (const float*)(ws + SM_RSLIST), tab};
        pg8::gemm_phase(F.lds, (const bf16*)(ws + WS_HB), (unsigned)S * P8, Sm, E);
        if (BOTH(7)) GRID_BAR(7);
    }
    if (IN(8)) { REFRAME();
        moe_tables(F);
        pg8::SchedMoE<false> Sm; Sm.NT = 4; Sm.G = F.G; Sm.c = F.bid; Sm.ntot = tab[32 + 32] * 4; Sm.Bt = (const bf16*)(ws + WS_W2); Sm.estride = (unsigned)D * P8; Sm.Bbytes = 32u * D * P8;
        Sm.cnt = tab; Sm.tile_start = tab + 32; Sm.row_start = tab + 65; Sm.mt_expert = tab + 97; Sm.list = nullptr;
        pg8::EpiMoE2 E{ws + WS_Y2, in[I_B2]};
        pg8::gemm_phase(F.lds, (const bf16*)(ws + WS_ACT), (unsigned)MAXMT * 256u * P8, Sm, E);
        if (BOTH(8)) GRID_BAR(8);
    }
    if (IN(9)) { REFRAME();
        moe_tables(F);
        for (int b = F.bid; b < NTILE; b += F.G) combine_tile2(F, b);
    }
#undef IN
#undef BOTH
}

extern "C" void kernel_launch(void* const* d_in, const int* in_sizes, int n_in, void* d_out, int out_size, void* d_ws, size_t ws_size, hipStream_t stream) {
    static int grid = 0;
    if (grid == 0) {
        if (n_in != 29 || out_size != S * D || ws_size < WS_END) { fprintf(stderr, "kernel_launch: unexpected problem (n_in %d, out %d, ws %zu)\n", n_in, out_size, ws_size); grid = -1; return; }
        int dev = 0, cus = 0, per_cu = 0;
        if (hipGetDevice(&dev) != hipSuccess || hipDeviceGetAttribute(&cus, hipDeviceAttributeMultiprocessorCount, dev) != hipSuccess) { grid = -1; return; }
        if (hipFuncSetAttribute((const void*)hymba_fwd, hipFuncAttributeMaxDynamicSharedMemorySize, LDS_BYTES) != hipSuccess) { fprintf(stderr, "kernel_launch: hipFuncSetAttribute failed\n"); grid = -1; return; }
        if (hipOccupancyMaxActiveBlocksPerMultiprocessor(&per_cu, (const void*)hymba_fwd, NTHR, LDS_BYTES) != hipSuccess || per_cu < 1) fprintf(stderr, "kernel_launch: occupancy query reports %d\n", per_cu);
        (void)hipGetLastError();
        grid = cus;
    }
    if (grid < 0) return;
    if (hipMemsetAsync((char*)d_ws + WS_CTL, 0, CTL_ZERO_BYTES, stream) != hipSuccess) return;
    Args a{};
    for (int i = 0; i < 29; ++i) a.in[i] = (const float*)d_in[i];
    a.out = (float*)d_out; a.ws = (unsigned char*)d_ws;
    if (N_LAUNCHES == 1) { a.ph_lo = 0; a.ph_hi = PER_PHASE; hipLaunchKernelGGL(hymba_fwd, dim3(grid), dim3(NTHR), LDS_BYTES, stream, a); }
    else for (int li = 0; li < PER_PHASE; ++li) { a.ph_lo = li; a.ph_hi = li + 1; hipLaunchKernelGGL(hymba_fwd, dim3(grid), dim3(NTHR), LDS_BYTES, stream, a); }
}
```

```cpp
#include <hip/hip_runtime.h>
#include <cstdio>
#include <cstdint>

#ifndef MK_N_LAUNCHES
#define MK_N_LAUNCHES 1
#endif

#define LAS __attribute__((address_space(3)))
#define GAS __attribute__((address_space(1)))
typedef unsigned short bf16;
typedef short bf16x8 __attribute__((ext_vector_type(8)));
typedef float f32x4 __attribute__((ext_vector_type(4)));
typedef float f32x2 __attribute__((ext_vector_type(2)));
typedef unsigned u32x4 __attribute__((ext_vector_type(4)));
typedef unsigned u32x2 __attribute__((ext_vector_type(2)));
typedef GAS unsigned gu32;

constexpr int S = 16384, D = 1024, D_IN = 1664, D_INP = 1792, MEM_LEN = 256;
constexpr int OFF_LRU = 0, OFF_GATE = 384, OFF_Q = 768, OFF_K = 1152, OFF_V = 1280, OFF_QM = 1408;
constexpr int NE = 32, CAP = 16384, MAXMT = 288, FF2 = 2048;
constexpr float EPS = 1e-6f;
constexpr float YSCALE = 8.0f;
constexpr float WSCALE = 64.0f;
constexpr int P8 = 1152;
constexpr int NTILE = S / 64;

constexpr size_t MiB = 1u << 20;
constexpr size_t WS_CTL = 0, CTL_ZERO_BYTES = 1 * MiB;
constexpr size_t WS_WIN = 1 * MiB;
constexpr size_t WS_WOUT = 5 * MiB;
constexpr size_t WS_SMALL = 7 * MiB;
constexpr size_t SM_KM = WS_SMALL;
constexpr size_t SM_VM = SM_KM + 128 * 1024;
constexpr size_t SM_VMT = SM_VM + 128 * 1024;
constexpr size_t SM_WAT = SM_VMT + 128 * 1024;
constexpr size_t SM_WXT = SM_WAT + 64 * 1024;
constexpr size_t SM_AAGG = SM_WXT + 64 * 1024;
constexpr size_t SM_BAGG = SM_AAGG + 384 * 1024;
constexpr size_t SM_RSTD1 = SM_BAGG + 384 * 1024;
constexpr size_t SM_RSTD2 = SM_RSTD1 + 64 * 1024;
constexpr size_t SM_TOKSLOT = SM_RSTD2 + 64 * 1024;
constexpr size_t SM_GATE = SM_TOKSLOT + 256 * 1024;
constexpr size_t SM_SSQP = SM_GATE + 256 * 1024;
constexpr size_t SM_B1P = SM_SSQP + 1024 * 1024;
constexpr size_t SM_LIST = 12 * MiB;
constexpr size_t SM_RSLIST = 14 * MiB;
constexpr size_t SM_CARRY = SM_B1P + 256 * 1024;
constexpr size_t SM_WRH = SM_CARRY + 384 * 1024;
constexpr size_t SM_WRL = SM_WRH + 64 * 1024;
static_assert(SM_WRL + 64 * 1024 <= SM_LIST, "small map");
constexpr size_t WS_XB = 16 * MiB;
constexpr size_t WS_U = 48 * MiB;
constexpr size_t WS_Y = 104 * MiB;
constexpr size_t WS_HB = 136 * MiB;
constexpr size_t WS_YP = 648 * MiB;
constexpr size_t WS_W1 = 168 * MiB;
constexpr size_t WS_W2 = 296 * MiB;
constexpr size_t WS_ACT = 360 * MiB;
constexpr size_t WS_Y2 = 504 * MiB;
constexpr size_t WS_HBF = 672 * MiB;
constexpr size_t WS_END = 704 * MiB;
constexpr int CW_TMO = 0, CW_CODE = 1;
constexpr int CW_BAR = 4096;
constexpr int CW_CNT = 8192;

constexpr int RING_BYTES = 131072;
constexpr int LDSCTL_OFF = RING_BYTES, MISC_OFF = LDSCTL_OFF + 320;
constexpr int TAB_OFF = RING_BYTES + 1024;
constexpr int PTAB_OFF = RING_BYTES + 4096;
constexpr int LDS_BYTES = 147456;

typedef __bf16 bf16x2_t __attribute__((ext_vector_type(2)));
__device__ __forceinline__ unsigned pk2(float lo, float hi) { const f32x2 v = {lo, hi}; return __builtin_bit_cast(unsigned, __builtin_convertvector(v, bf16x2_t)); }
__device__ __forceinline__ unsigned f2bf(float f) { return pk2(f, 0.f) & 0xffffu; }
__device__ __forceinline__ float bflo(unsigned w) { return __uint_as_float(w << 16); }
__device__ __forceinline__ float bfhi(unsigned w) { return __uint_as_float(w & 0xffff0000u); }
__device__ __forceinline__ float bf1(bf16 b) { return __uint_as_float(((unsigned)b) << 16); }
#define LDS_WAIT() asm volatile("s_waitcnt lgkmcnt(0)" ::: "memory")
#define VM_WAIT() asm volatile("s_waitcnt vmcnt(0)" ::: "memory")
#define RLX_AGENT __ATOMIC_RELAXED, __HIP_MEMORY_SCOPE_AGENT

namespace pg8 {
#define PG8_LAS __attribute__((address_space(3)))
constexpr int BM = 256, BK = 64, HALF = 128, HTB = HALF * BK * 2, STAGE_BYTES = 8 * HTB, NXCD = 8, WGM = 8, KD = 1024;
typedef int i32x4 __attribute__((ext_vector_type(4)));
typedef int i32x8 __attribute__((ext_vector_type(8)));
__device__ __forceinline__ float fp8_sat(float x) { return __builtin_fminf(__builtin_fmaxf(x, -448.0f), 448.0f); }
__device__ __forceinline__ unsigned pk4_fp8(float a, float b, float c, float d) { int w = 0; w = __builtin_amdgcn_cvt_pk_fp8_f32(fp8_sat(a), fp8_sat(b), w, false); w = __builtin_amdgcn_cvt_pk_fp8_f32(fp8_sat(c), fp8_sat(d), w, true); return (unsigned)w; }
constexpr int W2_PASSES = 32 * 16 * 32, W1_PASSES = 32 * 16 * 64, W2SCR_OFF = 131072 + 6144, W2SCR_WAVE = 1280;
template <bool IS1> __device__ __forceinline__ void wq_pass_load(f32x4 (&v)[2][4], const float* w, int q, int lane) {
    constexpr int N = IS1 ? 2048 : 1024, NBL = IS1 ? 6 : 5;
    const int e = q >> (4 + NBL), rem = q & ((16 << NBL) - 1), kb = rem >> NBL, nb = rem & ((1 << NBL) - 1); const float* W = w + (size_t)e * 1024 * N + (size_t)(64 * kb) * N + 32 * nb + 4 * (lane & 7);
#pragma unroll
    for (int grp = 0; grp < 2; ++grp)
#pragma unroll
        for (int ee = 0; ee < 4; ++ee) v[grp][ee] = __builtin_nontemporal_load((const f32x4*)(W + (size_t)(32 * grp + 4 * (lane >> 3) + ee) * N));
}
template <bool IS1> __device__ __forceinline__ void wq_pass_emit(const f32x4 (&v)[2][4], unsigned char* wt, int q, PG8_LAS unsigned char* scr, int lane, float scale) {
    constexpr int N = IS1 ? 2048 : 1024, NBL = IS1 ? 6 : 5;
    const int e = q >> (4 + NBL), rem = q & ((16 << NBL) - 1), kb = rem >> NBL, nb = rem & ((1 << NBL) - 1), r = lane >> 3, c = lane & 7;
    unsigned w[4][2];
#pragma unroll
    for (int comp = 0; comp < 4; ++comp)
#pragma unroll
        for (int grp = 0; grp < 2; ++grp) w[comp][grp] = pk4_fp8(v[grp][0][comp] * scale, v[grp][1][comp] * scale, v[grp][2][comp] * scale, v[grp][3][comp] * scale);
    unsigned char* dst = wt + (size_t)e * N * P8 + 64 * kb;
#pragma unroll
    for (int hh = 0; hh < 2; ++hh) {
        if ((c >> 2) == hh) {
#pragma unroll
            for (int comp = 0; comp < 4; ++comp)
#pragma unroll
                for (int grp = 0; grp < 2; ++grp) *(PG8_LAS unsigned*)(scr + (4 * (c & 3) + comp) * 80 + (8 * grp + r) * 4) = w[comp][grp];
        }
        asm volatile("s_waitcnt lgkmcnt(0)" ::: "memory");
        const u32x4 o = *(const PG8_LAS u32x4*)(scr + (lane >> 2) * 80 + (lane & 3) * 16);
        int nn = 32 * nb + 16 * hh + (lane >> 2); if (IS1) { const int a = nn >> 1, s1 = nn & 1; nn = 256 * (a >> 7) + 128 * s1 + (a & 127); }
        *(u32x4*)(dst + (size_t)nn * P8 + 16 * (lane & 3)) = o;
        asm volatile("s_waitcnt lgkmcnt(0)" ::: "memory");
    }
}
__device__ __forceinline__ void w2_pass_load(f32x4 (&v)[2][4], const float* w2, int q, int lane) { wq_pass_load<false>(v, w2, q, lane); }
__device__ __forceinline__ void w2_pass_load_grp(f32x4 (&v)[2][4], const float* w2, int q, int lane, int grp) {
    const int e = q >> 9, rem = q & 511, kb = rem >> 5, nb = rem & 31; const float* W = w2 + (size_t)e * 1024 * 1024 + (size_t)(64 * kb) * 1024 + 32 * nb + 4 * (lane & 7);
#pragma unroll
    for (int ee = 0; ee < 4; ++ee) v[grp][ee] = __builtin_nontemporal_load((const f32x4*)(W + (size_t)(32 * grp + 4 * (lane >> 3) + ee) * 1024));
}
__device__ __forceinline__ void w2_pass_emit(const f32x4 (&v)[2][4], unsigned char* w2t, int q, PG8_LAS unsigned char* scr, int lane, float scale) { wq_pass_emit<false>(v, w2t, q, scr, lane, scale); }
struct W1Rider { const float* w1; unsigned char* w1t; PG8_LAS unsigned char* scr; int q, qstep, qlive, qend; f32x4 v[2][4];
    __device__ __forceinline__ void init(const float* w1_, unsigned char* w1t_, PG8_LAS unsigned char* lds, int gw, int ngw, int wid, int j0, int j1, int qcap) { w1 = w1_; w1t = w1t_; scr = lds + W2SCR_OFF + wid * W2SCR_WAVE; q = gw + ngw * j0; qstep = ngw; qlive = -1; const long long e = (long long)gw + (long long)ngw * j1; qend = e < qcap ? (int)e : qcap; }
    __device__ __forceinline__ void init_x(const float* w1_, unsigned char* w1t_, PG8_LAS unsigned char* lds, int wid, int q0, int step, int qe) { w1 = w1_; w1t = w1t_; scr = lds + W2SCR_OFF + wid * W2SCR_WAVE; q = q0; qstep = step; qlive = -1; qend = qe; }
    __device__ __forceinline__ void issue(int lane) { if (q < qend) { wq_pass_load<true>(v, w1, q, lane); qlive = q; q += qstep; } else qlive = -1; }
    __device__ __forceinline__ void retire(int lane) { if (qlive >= 0) wq_pass_emit<true>(v, w1t, qlive, scr, lane, WSCALE); qlive = -1; }
    __device__ __forceinline__ void ride(int lane) { if (qlive >= 0) wq_pass_emit<true>(v, w1t, qlive, scr, lane, WSCALE); if (q < qend) { wq_pass_load<true>(v, w1, q, lane); qlive = q; q += qstep; } else qlive = -1; }
    __device__ __forceinline__ void drain(int lane) { if (qlive < 0) ride(lane); while (qlive >= 0) ride(lane); }
    __device__ __forceinline__ void issue3(f32x4 (&va)[2][4], f32x4 (&vb)[2][4], int& qa, int& qb, int lane) { issue(lane); qa = -1; qb = -1;
        if (q < qend) { qa = q; q += qstep; wq_pass_load<true>(va, w1, qa, lane); } if (q < qend) { qb = q; q += qstep; wq_pass_load<true>(vb, w1, qb, lane); } }
    __device__ __forceinline__ void retire3(const f32x4 (&va)[2][4], const f32x4 (&vb)[2][4], int qa, int qb, int lane) { retire(lane);
        if (qa >= 0) wq_pass_emit<true>(va, w1t, qa, scr, lane, WSCALE); if (qb >= 0) wq_pass_emit<true>(vb, w1t, qb, scr, lane, WSCALE); }
    __device__ __forceinline__ void drain3(int lane) {
        retire(lane);
        f32x4 va[2][4], vb[2][4]; int qa = -1, qb = -1, qc = -1;
        if (q < qend) { qa = q; q += qstep; wq_pass_load<true>(va, w1, qa, lane); }
        if (q < qend) { qb = q; q += qstep; wq_pass_load<true>(vb, w1, qb, lane); }
        while (qa >= 0) {
            if (q < qend) { qc = q; q += qstep; wq_pass_load<true>(v, w1, qc, lane); } else qc = -1;
            wq_pass_emit<true>(va, w1t, qa, scr, lane, WSCALE);
#pragma unroll
            for (int g2 = 0; g2 < 2; ++g2)
#pragma unroll
                for (int e2 = 0; e2 < 4; ++e2) { va[g2][e2] = vb[g2][e2]; vb[g2][e2] = v[g2][e2]; }
            qa = qb; qb = qc;
        }
    }
};
__host__ __device__ __forceinline__ int lds_byte(int r, int c) { const int st = (r >> 4) * 2 + (c >> 5), rr = r & 15, cc = c & 31, ob = rr * 64 + cc * 2; return st * 1024 + (ob ^ (((ob >> 9) & 1) << 5)); }
__host__ __device__ __forceinline__ void stage_rc(int b, int& R, int& C) { const int st = b / 1024, sb = b % 1024, swz = sb ^ (((sb >> 9) & 1) << 5); R = (st >> 1) * 16 + swz / 64; C = (st & 1) * 32 + (swz % 64) / 2; }
__host__ __device__ __forceinline__ int perm32(int rho) { const int n = rho >> 4, i = rho & 15; return 8 * (i >> 2) + 4 * n + (i & 3); }
__device__ __forceinline__ unsigned cvt_pk_bf16(float lo, float hi) { unsigned r; asm volatile("v_cvt_pk_bf16_f32 %0, %1, %2" : "=v"(r) : "v"(lo), "v"(hi)); return r; }

struct Unit { int pm, pn, e, rowbase; };

struct SchedDense {
    int nM, nN, nwg, G, c; const bf16* Bt; unsigned Bbytes;
    __device__ void init(int M, int N, int G_, int c_, const bf16* Bt_) { nM = M / BM; nN = N / BM; nwg = nM * nN; G = G_; c = c_; Bt = Bt_; Bbytes = (unsigned)N * KD * 2; }
    __device__ bool next(int i, Unit& u) const {
        const long L = (long)i * G + c; if (L >= nwg) return false;
        int wgid = (int)L; { const int q = nwg / NXCD, r = nwg % NXCD, xcd = wgid % NXCD, off = wgid / NXCD; wgid = (xcd < r ? xcd * (q + 1) : r * (q + 1) + (xcd - r) * q) + off; }
        const int nig = WGM * nN, gid = wgid / nig, fm = gid * WGM, gsz = (nM - fm) < WGM ? (nM - fm) : WGM;
        u.pm = fm + ((wgid % nig) % gsz); u.pn = (wgid % nig) / gsz; u.e = 0; u.rowbase = u.pm * BM; return true;
    }
    __device__ __forceinline__ unsigned arow(const Unit& u, int r) const { return (unsigned)(u.pm * BM + r); }
    __device__ __forceinline__ unsigned bbase(const Unit& u) const { return (unsigned)u.pn * (unsigned)(BM * KD * 2); }
    static constexpr bool GATHER = false;
    __device__ __forceinline__ unsigned abase(const Unit& u) const { return (unsigned)u.rowbase; }
};
template <bool GATHER_> struct SchedMoE {
    static constexpr bool GATHER = GATHER_;
    __device__ __forceinline__ unsigned abase(const Unit& u) const { return (unsigned)u.rowbase; }
    int NT, G, c, ntot; const bf16* Bt; unsigned Bbytes; unsigned estride;
    const PG8_LAS int* cnt; const PG8_LAS int* tile_start; const PG8_LAS int* row_start; const PG8_LAS int* mt_expert;
    const unsigned* list;
    __device__ bool next(int i, Unit& u) const {
        int mtg;
        if (G == 256) {
            const int x = c & 7, q = c >> 3, nsub = NT >> 2, item = i * 8 + x, chunk = item / nsub, hlf = item - chunk * nsub;
            mtg = chunk * 8 + (q & 7); u.pn = hlf * 4 + (q >> 3);
            if (mtg * NT >= ntot) return false;
        } else { const int L = i * G + c; if (L >= ntot) return false; mtg = L / NT; u.pn = L - mtg * NT; } u.e = __builtin_amdgcn_readfirstlane(mt_expert[mtg]); u.pm = mtg - __builtin_amdgcn_readfirstlane(tile_start[u.e]); u.rowbase = __builtin_amdgcn_readfirstlane(row_start[u.e]) + u.pm * BM; return true;
    }
    __device__ __forceinline__ unsigned arow(const Unit& u, int r) const {
        const int pos = min(u.pm * BM + r, cnt[u.e] - 1); return list[(size_t)u.e * CAP + pos];
    }
    __device__ __forceinline__ unsigned bbase(const Unit& u) const { return (unsigned)u.e * estride + (unsigned)u.pn * (unsigned)(BM * P8); }
};

struct EpiInProj {
    static constexpr bool LDSEPI = false, PREL = false;
    static constexpr bool RIDER = false;
    static constexpr bool PERM = true, FP8 = false;
    bf16* U; const float* rstd;
    __device__ __forceinline__ void operator()(const f32x4 (&acc)[2][2][4][2], const Unit& u, int wr, int wc, int fr, int fq) const {
        const int row0 = u.rowbase + wr * 64 + fr, col0 = u.pn * BM + wc * 32 + 8 * fq;
        float rsv[2][4];
#pragma unroll
        for (int ai = 0; ai < 2; ++ai)
#pragma unroll
            for (int m = 0; m < 4; ++m) rsv[ai][m] = rstd[row0 + ai * HALF + m * 16];
#pragma unroll
        for (int ai = 0; ai < 2; ++ai)
#pragma unroll
            for (int m = 0; m < 4; ++m) { const int row = row0 + ai * HALF + m * 16; const float rs = rsv[ai][m]; bf16* rowp = U + (size_t)row * D_INP + col0;
#pragma unroll
                for (int bj = 0; bj < 2; ++bj) { const f32x4 v0 = acc[ai][bj][m][0] * rs, v1 = acc[ai][bj][m][1] * rs;
                    u32x4 w; w.x = cvt_pk_bf16(v0[0], v0[1]); w.y = cvt_pk_bf16(v0[2], v0[3]); w.z = cvt_pk_bf16(v1[0], v1[1]); w.w = cvt_pk_bf16(v1[2], v1[3]);
                    *(u32x4*)(rowp + bj * HALF) = w; } }
    }
};
struct EpiOutProj {
    static constexpr bool LDSEPI = false, PREL = true;
    static constexpr bool RIDER = false;
    static constexpr bool PERM = true, FP8 = false;
    const bf16* xb; bf16* hbf; unsigned char* HB8; float* ssqp; const float* gffn;
    __device__ __forceinline__ void xload(u32x4 (&xv)[2][2], int row0, int col0, int ai, int mp) const {
#pragma unroll
        for (int mm = 0; mm < 2; ++mm)
#pragma unroll
            for (int bj = 0; bj < 2; ++bj) { const size_t o = (size_t)(row0 + ai * HALF + (2 * mp + mm) * 16) * D + col0 + bj * HALF;
                xv[mm][bj] = __builtin_nontemporal_load((const u32x4*)(xb + o)); }
    }
    struct Bias { f32x4 gf[2][2]; u32x4 x0[2][2]; };
    __device__ __forceinline__ void load_bias(const Unit& u, int wr, int wc, int fr, int fq, Bias& b) const {
        const int row0 = u.rowbase + wr * 64 + fr, col0 = u.pn * BM + wc * 32 + 8 * fq;
#pragma unroll
        for (int bj = 0; bj < 2; ++bj) { b.gf[bj][0] = *(const f32x4*)(gffn + col0 + bj * HALF); b.gf[bj][1] = *(const f32x4*)(gffn + col0 + bj * HALF + 4); }
        xload(b.x0, row0, col0, 0, 0);
    }
    __device__ __forceinline__ void operator()(const f32x4 (&acc)[2][2][4][2], const Unit& u, int wr, int wc, int fr, int fq, const Bias& pre) const {
        const int row0 = u.rowbase + wr * 64 + fr, col0 = u.pn * BM + wc * 32 + 8 * fq;
        f32x4 gf[2][2];
#pragma unroll
        for (int bj = 0; bj < 2; ++bj) { gf[bj][0] = pre.gf[bj][0]; gf[bj][1] = pre.gf[bj][1]; }
        u32x4 xv[2][2][2];
#pragma unroll
        for (int mm = 0; mm < 2; ++mm)
#pragma unroll
            for (int bj = 0; bj < 2; ++bj) xv[0][mm][bj] = pre.x0[mm][bj];
#pragma unroll
        for (int b = 0; b < 4; ++b) { const int ai = b >> 1, mp = b & 1;
            if (b < 3) xload(xv[(b + 1) & 1], row0, col0, (b + 1) >> 1, (b + 1) & 1);
#pragma unroll
            for (int mm = 0; mm < 2; ++mm) { const int m = 2 * mp + mm, row = row0 + ai * HALF + m * 16; const size_t off = (size_t)row * D + col0; float sq = 0.f;
#pragma unroll
                for (int bj = 0; bj < 2; ++bj) { const size_t o = off + bj * HALF; const u32x4 xw = xv[b & 1][mm][bj]; const f32x4 h0 = (f32x4){bflo(xw.x), bfhi(xw.x), bflo(xw.y), bfhi(xw.y)} + acc[ai][bj][m][0], h1 = (f32x4){bflo(xw.z), bfhi(xw.z), bflo(xw.w), bfhi(xw.w)} + acc[ai][bj][m][1];
                    { u32x4 hw; hw.x = cvt_pk_bf16(h0[0], h0[1]); hw.y = cvt_pk_bf16(h0[2], h0[3]); hw.z = cvt_pk_bf16(h1[0], h1[1]); hw.w = cvt_pk_bf16(h1[2], h1[3]); *(u32x4*)(hbf + o) = hw; }
                    const f32x4 s0 = h0 * gf[bj][0], s1 = h1 * gf[bj][1]; u32x2 w; w.x = pk4_fp8(s0[0], s0[1], s0[2], s0[3]); w.y = pk4_fp8(s1[0], s1[1], s1[2], s1[3]); *(u32x2*)(HB8 + (size_t)row * P8 + col0 + bj * HALF) = w;
                    sq += ((h0[0] * h0[0] + h0[1] * h0[1]) + (h0[2] * h0[2] + h0[3] * h0[3])) + ((h1[0] * h1[0] + h1[1] * h1[1]) + (h1[2] * h1[2] + h1[3] * h1[3])); }
                sq += __shfl_xor(sq, 16); sq += __shfl_xor(sq, 32);
                if (fq == 0) ssqp[(size_t)row * 16 + u.pn * 4 + wc] = sq; } }
    }
};
struct EpiMoE1 {
    static constexpr bool LDSEPI = false, PREL = false;
    static constexpr bool RIDER = true; const float* w2; unsigned char* w2t;
    static constexpr bool PERM = true, FP8 = true;
    unsigned char* ACT; const float* b1p; const float* rslist; const PG8_LAS int* cnt;
    struct Pre { f32x4 bg0, bg1, bl0, bl1; float rsv[2][4]; };
    __device__ __forceinline__ void prep(const Unit& u, int wr, int wc, int fr, int fq, Pre& p) const {
        const int r0 = wr * 64 + fr, cb = wc * 32 + 8 * fq; const int last = cnt[u.e] - 1 - u.pm * BM;
        const float* bp = b1p + (size_t)u.e * FF2 + u.pn * BM + cb; const float* rsp = rslist + (size_t)u.e * CAP + u.pm * BM;
        p.bg0 = *(const f32x4*)(bp); p.bg1 = *(const f32x4*)(bp + 4); p.bl0 = *(const f32x4*)(bp + HALF); p.bl1 = *(const f32x4*)(bp + HALF + 4);
#pragma unroll
        for (int ai = 0; ai < 2; ++ai)
#pragma unroll
            for (int m = 0; m < 4; ++m) p.rsv[ai][m] = rsp[min(r0 + ai * HALF + m * 16, last)] * (1.0f / WSCALE);
    }
    __device__ __forceinline__ void operator()(const f32x4 (&acc)[2][2][4][2], const Unit& u, int wr, int wc, int fr, int fq) const { Pre p; prep(u, wr, wc, fr, fq, p); half(acc, u, wr, wc, fr, fq, 0, p); half(acc, u, wr, wc, fr, fq, 1, p); }
    __device__ __forceinline__ void half(const f32x4 (&acc)[2][2][4][2], const Unit& u, int wr, int wc, int fr, int fq, const int ai, const Pre& p) const {
        const int r0 = wr * 64 + fr, cb = wc * 32 + 8 * fq;
        const f32x4 bg0 = p.bg0, bg1 = p.bg1, bl0 = p.bl0, bl1 = p.bl1;
#pragma unroll
            for (int m = 0; m < 4; ++m) { const int r = r0 + ai * HALF + m * 16; const float rs = p.rsv[ai][m];
                const f32x4 ga[2] = {acc[ai][0][m][0], acc[ai][0][m][1]}, la[2] = {acc[ai][1][m][0], acc[ai][1][m][1]}; const f32x4 bgv[2] = {bg0, bg1}, blv[2] = {bl0, bl1};
                unsigned wv[2];
#pragma unroll
                for (int h = 0; h < 2; ++h) { int pk = 0;
#pragma unroll
                    for (int pr = 0; pr < 2; ++pr) {
                        f32x2 G = (f32x2){ga[h][2 * pr], ga[h][2 * pr + 1]} * rs + (f32x2){bgv[h][2 * pr], bgv[h][2 * pr + 1]};
                        f32x2 L = (f32x2){la[h][2 * pr], la[h][2 * pr + 1]} * rs + (f32x2){blv[h][2 * pr], blv[h][2 * pr + 1]};
                        G.x = fminf(G.x, 7.0f); G.y = fminf(G.y, 7.0f);
                        L.x = fminf(fmaxf(L.x, -7.0f), 7.0f); L.y = fminf(fmaxf(L.y, -7.0f), 7.0f);
                        const f32x2 E = G * (-1.702f * 1.4426950408889634f);
                        f32x2 D; D.x = __builtin_amdgcn_exp2f(E.x); D.y = __builtin_amdgcn_exp2f(E.y); D = D + 1.0f;
                        f32x2 R; R.x = __builtin_amdgcn_rcpf(D.x); R.y = __builtin_amdgcn_rcpf(D.y);
                        const f32x2 O = (G * R) * (L + 1.0f);
                        if (pr == 0) pk = __builtin_amdgcn_cvt_pk_fp8_f32(O.x, O.y, pk, false); else pk = __builtin_amdgcn_cvt_pk_fp8_f32(O.x, O.y, pk, true); }
                    wv[h] = (unsigned)pk; }
                u32x2 w; w.x = wv[0]; w.y = wv[1];
                *(u32x2*)(ACT + (size_t)(u.rowbase + r) * P8 + u.pn * HALF + cb) = w; }
    }
};
struct EpiMoE2 {
    static constexpr bool PERM = true, FP8 = true;
    static constexpr int RIDER = 0; static constexpr bool LDSEPI = true, PREL = true;
    unsigned char* Y2; const float* b2;
    struct Bias { f32x4 v[2][2]; };
    __device__ __forceinline__ void load_bias(const Unit& u, int wr, int wc, int fr, int fq, Bias& b) const { const int col0 = u.pn * BM + wc * 32 + 8 * fq;
#pragma unroll
        for (int bj = 0; bj < 2; ++bj)
#pragma unroll
            for (int n = 0; n < 2; ++n) b.v[bj][n] = *(const f32x4*)(b2 + (size_t)u.e * D + col0 + bj * HALF + 4 * n); }
    __device__ __forceinline__ void operator()(const f32x4 (&acc)[2][2][4][2], const Unit& u, int wr, int wc, int fr, int fq, PG8_LAS unsigned char* lds, int tid, const Bias& bias) const {
        PG8_LAS unsigned char* buf = lds + 3 * HTB;
        f32x4 bv[2][2];
#pragma unroll
        for (int bj = 0; bj < 2; ++bj)
#pragma unroll
            for (int n = 0; n < 2; ++n) bv[bj][n] = bias.v[bj][n] * YSCALE;
#pragma unroll
        for (int s = 0; s < 4; ++s) {
            const int ai = s >> 1;
            if (wr == (s & 1)) {
#pragma unroll
                for (int m = 0; m < 4; ++m) { const int row = 16 * m + fr;
#pragma unroll
                    for (int bj = 0; bj < 2; ++bj) { const f32x4 v0 = acc[ai][bj][m][0] * (YSCALE / WSCALE) + bv[bj][0], v1 = acc[ai][bj][m][1] * (YSCALE / WSCALE) + bv[bj][1];
                        u32x2 w; w.x = pk4_fp8(v0[0], v0[1], v0[2], v0[3]); w.y = pk4_fp8(v1[0], v1[1], v1[2], v1[3]);
                        const int ch = 8 * bj + 2 * wc + (fq >> 1);
                        *(PG8_LAS u32x2*)(buf + row * 256 + ((ch ^ fr) << 4) + 8 * (fq & 1)) = w; } }
            }
            asm volatile("s_waitcnt lgkmcnt(0)" ::: "memory"); __builtin_amdgcn_s_barrier(); asm volatile("" ::: "memory");
#pragma unroll
            for (int k = 0; k < 2; ++k) { const int ci = tid + 512 * k, row = ci >> 4, ch = ci & 15;
                const u32x4 o = *(const PG8_LAS u32x4*)(buf + row * 256 + ((ch ^ (row & 15)) << 4));
                __builtin_nontemporal_store(o, (u32x4*)(Y2 + (size_t)(u.rowbase + 64 * s + row) * D + u.pn * BM + 16 * ch)); }
            asm volatile("s_waitcnt lgkmcnt(0)" ::: "memory"); __builtin_amdgcn_s_barrier(); asm volatile("" ::: "memory");
        }
    }
};

struct NoBias {};
template <class E, bool L = E::PREL> struct BiasOf { typedef NoBias type; };
template <class E> struct BiasOf<E, true> { typedef typename E::Bias type; };
template <class Epi, class Sched>
__device__ __forceinline__ void gemm_phase(PG8_LAS unsigned char* lds, const bf16* Abase, unsigned Abytes, const Sched& S, const Epi& E) {
    int tid = threadIdx.x; asm volatile("" : "+v"(tid));
    const int wid = __builtin_amdgcn_readfirstlane(tid >> 6), lane = tid & 63, wr = wid >> 2, wc = wid & 3, fr = lane & 15, fq = lane >> 4;
    constexpr bool FP8 = Epi::FP8; constexpr int PITCH = FP8 ? P8 : KD * 2; constexpr int nt = FP8 ? KD / 128 : KD / BK;
    int R0, C0; stage_rc(tid * 16, R0, C0);
    unsigned voffB[2];
#pragma unroll
    for (int i = 0; i < 2; ++i) { const int R = R0 + 64 * i; const int Rb = Epi::PERM ? ((R & ~31) + perm32(R & 31)) : R; voffB[i] = (unsigned)(Rb * PITCH + C0 * 2); }
    constexpr unsigned kstep = (unsigned)(BK * 2);
    constexpr unsigned hstep = (unsigned)HALF * PITCH;
    const unsigned ldsw = (unsigned)wid * 1024u;
    const int aoff = lds_byte(wr * 64 + fr, fq * 8), boff = lds_byte(wc * 32 + fr, fq * 8);
    const __amdgpu_buffer_rsrc_t rsA = __builtin_amdgcn_make_buffer_rsrc((void*)Abase, (short)0, (int)Abytes, 0x00020000);
    const __amdgpu_buffer_rsrc_t rsB = __builtin_amdgcn_make_buffer_rsrc((void*)S.Bt, (short)0, (int)S.Bbytes, 0x00020000);
#define PG8_SA(b, h) (((b) * 2 + (h)) * HTB)
#define PG8_SB(b, h) ((4 + (b) * 2 + (h)) * HTB)
#define PG8_STAGE(bufoff, soff, voff) do { _Pragma("unroll") for (int _i = 0; _i < 2; ++_i) \
        __builtin_amdgcn_raw_ptr_buffer_load_lds(rsB, (PG8_LAS void*)(lds + (bufoff) + ldsw + _i * 8192), 16, (int)(voff)[_i], (int)(soff), 0, 0); } while (0)
#define PG8_STAGEA(bufoff, H, kb, NEXT) do { \
        if constexpr (Sched::GATHER) { const unsigned _tk = (NEXT) ? ((H) ? nt1 : nt0) : ((H) ? ct1 : ct0); \
            __builtin_amdgcn_raw_ptr_buffer_load_lds(rsA, (PG8_LAS void*)(lds + (bufoff) + ldsw), 16, (int)((_tk & 0xffffu) * (unsigned)PITCH + (unsigned)(C0 * 2)), (int)(kb), 0, 0); \
            __builtin_amdgcn_raw_ptr_buffer_load_lds(rsA, (PG8_LAS void*)(lds + (bufoff) + ldsw + 8192), 16, (int)((_tk >> 16) * (unsigned)PITCH + (unsigned)(C0 * 2)), (int)(kb), 0, 0); } \
        else { const unsigned _sb = ((NEXT) ? nA : cA) + (H) * hstep + (kb); \
            __builtin_amdgcn_raw_ptr_buffer_load_lds(rsA, (PG8_LAS void*)(lds + (bufoff) + ldsw), 16, (int)voffA0, (int)_sb, 0, 0); \
            __builtin_amdgcn_raw_ptr_buffer_load_lds(rsA, (PG8_LAS void*)(lds + (bufoff) + ldsw + 8192), 16, (int)voffA0, (int)(_sb + 64u * PITCH), 0, 0); } } while (0)
#define PG8_LDA(dst, b, h) do { _Pragma("unroll") for (int m = 0; m < 4; ++m) _Pragma("unroll") for (int k = 0; k < 2; ++k) dst[m][k] = *(const PG8_LAS bf16x8*)(lds + PG8_SA(b, h) + aoff + m * 2048 + k * 1024); } while (0)
#define PG8_LDB(dst, b, h) do { _Pragma("unroll") for (int n = 0; n < 2; ++n) _Pragma("unroll") for (int k = 0; k < 2; ++k) dst[n][k] = *(const PG8_LAS bf16x8*)(lds + PG8_SB(b, h) + boff + n * 2048 + k * 1024); } while (0)
#define PG8_CAT(f) __builtin_shufflevector(__builtin_bit_cast(i32x4, (f)[0]), __builtin_bit_cast(i32x4, (f)[1]), 0, 1, 2, 3, 4, 5, 6, 7)
#define PG8_MMA(ai, bj, At, Bt) do { __builtin_amdgcn_s_setprio(1); _Pragma("unroll") for (int m = 0; m < 4; ++m) _Pragma("unroll") for (int n = 0; n < 2; ++n) { \
        if constexpr (FP8) { const i32x8 _b = PG8_CAT(Bt[n]), _a = PG8_CAT(At[m]); asm volatile("v_mfma_scale_f32_16x16x128_f8f6f4 %0, %1, %2, %0, %3, %3 op_sel_hi:[0,0,0]" : "+v"(acc[ai][bj][m][n]) : "v"(_b), "v"(_a), "v"(scale1)); }   \
        else { _Pragma("unroll") for (int k = 0; k < 2; ++k) acc[ai][bj][m][n] = __builtin_amdgcn_mfma_f32_16x16x32_bf16(Bt[n][k], At[m][k], acc[ai][bj][m][n], 0, 0, 0); } } \
        __builtin_amdgcn_s_setprio(0); } while (0)
#define PG8_WAIT_V(n) asm volatile("s_waitcnt vmcnt(" #n ")" ::: "memory")
#define PG8_WAIT_L(n) asm volatile("s_waitcnt lgkmcnt(" #n ")" ::: "memory")
#define PG8_BAR __builtin_amdgcn_s_barrier()
#define PG8_SCHED __builtin_amdgcn_sched_barrier(0)
#define PG8_TOK2(u, h) (S.arow(u, (h) * HALF + R0) | (S.arow(u, (h) * HALF + R0 + 64) << 16))
    Unit cur, nxt; int ui = 0;
    if (!S.next(0, cur)) {
        if constexpr (Epi::RIDER) { for (int u2 = 0; ; ++u2) { const int q = (u2 * (int)gridDim.x + (int)blockIdx.x) * 8 + wid; if (q >= W2_PASSES) break;
            f32x4 rv[2][4]; w2_pass_load(rv, E.w2, q, lane); w2_pass_emit(rv, E.w2t, q, lds + W2SCR_OFF + wid * W2SCR_WAVE, lane, WSCALE); } }
        return; }
    f32x4 acc[2][2][4][2];
#pragma unroll
    for (int a = 0; a < 2; ++a)
#pragma unroll
        for (int b = 0; b < 2; ++b)
#pragma unroll
            for (int m = 0; m < 4; ++m)
#pragma unroll
                for (int n = 0; n < 2; ++n) acc[a][b][m][n] = (f32x4){0.f, 0.f, 0.f, 0.f};
    bf16x8 At[4][2], B0[2][2], B1[2][2];
    const int scale1 = 0x7F7F7F7F;
    const unsigned voffA0 = (unsigned)(R0 * PITCH + C0 * 2);
    unsigned ct0 = 0, ct1 = 0, nt0 = 0, nt1 = 0, cA = 0, nA = 0;
    bool has_next = S.next(1, nxt);
    [[maybe_unused]] typename BiasOf<Epi>::type bcur, bnxt;
    if constexpr (Epi::PREL) { E.load_bias(cur, wr, wc, fr, fq, bcur); if constexpr (Epi::LDSEPI) { bnxt = bcur;
#pragma unroll
        for (int i = 0; i < 4; ++i) asm volatile("" : "+v"(bcur.v[i >> 1][i & 1])); } }
    if constexpr (Sched::GATHER) { ct0 = PG8_TOK2(cur, 0); ct1 = PG8_TOK2(cur, 1); nt0 = ct0; nt1 = ct1; if (has_next) { nt0 = PG8_TOK2(nxt, 0); nt1 = PG8_TOK2(nxt, 1); } } else cA = S.abase(cur) * (unsigned)PITCH;
    unsigned cB = S.bbase(cur);
    PG8_STAGE(PG8_SB(0, 0), cB, voffB); PG8_STAGE(PG8_SB(0, 1), cB + hstep, voffB); PG8_STAGEA(PG8_SA(0, 0), 0, 0u, false); PG8_STAGEA(PG8_SA(0, 1), 1, 0u, false);
    if (wr == 1) PG8_BAR;
    PG8_WAIT_V(2); PG8_BAR;
    PG8_STAGE(PG8_SB(1, 0), cB + kstep, voffB); PG8_STAGEA(PG8_SA(1, 0), 0, kstep, false); PG8_STAGE(PG8_SB(1, 1), cB + hstep + kstep, voffB);
    PG8_WAIT_V(6); PG8_BAR;
    for (;;) {
        const unsigned nB = has_next ? S.bbase(nxt) : cB;
#define PG8_KBODY(LAST, t) do { \
            const unsigned kb1 = (unsigned)((t) + 1) * kstep; \
            const unsigned kb2 = (LAST) ? 0u : (unsigned)((t) + 2) * kstep; \
            const unsigned b2 = (LAST) ? nB : cB + (unsigned)((t) + 2) * kstep; const unsigned b3 = b2 + kstep; \
              \
            PG8_LDB(B0, 0, 0); PG8_LDB(B1, 0, 1); PG8_SCHED; PG8_LDA(At, 0, 0); PG8_STAGEA(PG8_SA(1, 1), 1, kb1, false); \
            PG8_WAIT_V(8); PG8_WAIT_L(0); PG8_BAR; PG8_MMA(0, 0, At, B0); PG8_MMA(0, 1, At, B1); PG8_BAR; PG8_SCHED; \
              \
            PG8_LDA(At, 0, 1); PG8_STAGE(PG8_SB(0, 0), b2, voffB); PG8_STAGE(PG8_SB(0, 1), b2 + hstep, voffB); PG8_STAGEA(PG8_SA(0, 0), 0, kb2, (LAST)); \
            PG8_WAIT_V(8); PG8_WAIT_L(0); PG8_BAR; PG8_MMA(1, 0, At, B0); PG8_MMA(1, 1, At, B1); PG8_BAR; PG8_SCHED; \
              \
            PG8_LDB(B0, 1, 0); PG8_LDB(B1, 1, 1); PG8_SCHED; PG8_LDA(At, 1, 0); PG8_STAGEA(PG8_SA(0, 1), 1, kb2, (LAST)); \
            PG8_WAIT_V(8); PG8_WAIT_L(0); PG8_BAR; PG8_MMA(0, 0, At, B0); PG8_MMA(0, 1, At, B1); PG8_BAR; PG8_SCHED; \
              \
            PG8_LDA(At, 1, 1); PG8_STAGE(PG8_SB(1, 0), b3, voffB); PG8_STAGE(PG8_SB(1, 1), b3 + hstep, voffB); PG8_STAGEA(PG8_SA(1, 0), 0, kb2 + kstep, (LAST)); \
            PG8_WAIT_V(8); PG8_WAIT_L(0); PG8_BAR; PG8_MMA(1, 0, At, B0); PG8_MMA(1, 1, At, B1); PG8_BAR; PG8_SCHED; \
        } while (0)
#pragma unroll 1
        for (int t = 0; t < nt; t += 2) {
            const bool last = (t == nt - 2);
            if (last) { if constexpr (!Sched::GATHER) nA = has_next ? S.abase(nxt) * (unsigned)PITCH : cA; }
            PG8_KBODY(last, t);
        }
        if constexpr (FP8) asm volatile("s_nop 15\n\ts_nop 15\n\ts_nop 7" ::: "memory");
        if (wr == 0) PG8_BAR;
        Unit nn; bool has_nn = false; unsigned nn0 = nt0, nn1 = nt1;
        if (has_next) has_nn = S.next(ui + 2, nn);
        unsigned gr0 = 0, gr1 = 0, gr2 = 0, gr3 = 0;
        if constexpr (Sched::GATHER) { if (has_nn) { gr0 = S.arow(nn, R0); gr1 = S.arow(nn, R0 + 64); gr2 = S.arow(nn, HALF + R0); gr3 = S.arow(nn, HALF + R0 + 64); } }
        if constexpr (Epi::RIDER) {
            int tl = tid; asm volatile("" : "+v"(tl)); const int ln = tl & 63; const int q = (ui * (int)gridDim.x + (int)blockIdx.x) * 8 + wid;
            f32x4 rv[2][4]; const bool ride = q < W2_PASSES;
            typename Epi::Pre pre; E.prep(cur, wr, wc, tl & 15, (tl & 63) >> 4, pre);
            if (ride) w2_pass_load_grp(rv, E.w2, q, ln, 0);
            E.half(acc, cur, wr, wc, tl & 15, (tl & 63) >> 4, 0, pre);
            if (ride) w2_pass_load_grp(rv, E.w2, q, ln, 1);
            E.half(acc, cur, wr, wc, tl & 15, (tl & 63) >> 4, 1, pre);
            if (ride) w2_pass_emit(rv, E.w2t, q, lds + W2SCR_OFF + wid * W2SCR_WAVE, ln, WSCALE);
        } else
        { int tl = tid; asm volatile("" : "+v"(tl)); if constexpr (Epi::LDSEPI) { if (has_next) E.load_bias(nxt, wr, wc, fr, fq, bnxt); E(acc, cur, wr, wc, tl & 15, (tl & 63) >> 4, lds, tl, bcur);
#pragma unroll
              for (int i = 0; i < 4; ++i) asm volatile("" : "+v"(bnxt.v[i >> 1][i & 1])); bcur = bnxt; }
          else if constexpr (Epi::PREL) { E(acc, cur, wr, wc, tl & 15, (tl & 63) >> 4, bcur); if (has_next) E.load_bias(nxt, wr, wc, fr, fq, bcur); }
          else E(acc, cur, wr, wc, tl & 15, (tl & 63) >> 4); }
        if constexpr (Sched::GATHER) { asm volatile("" : "+v"(gr0), "+v"(gr1), "+v"(gr2), "+v"(gr3));
            if (has_nn) { nn0 = gr0 | (gr1 << 16); nn1 = gr2 | (gr3 << 16); } }
        if (!has_next) break;
#pragma unroll
        for (int a = 0; a < 2; ++a)
#pragma unroll
            for (int b = 0; b < 2; ++b)
#pragma unroll
                for (int m = 0; m < 4; ++m)
#pragma unroll
                    for (int n = 0; n < 2; ++n) acc[a][b][m][n] = (f32x4){0.f, 0.f, 0.f, 0.f};
        cur = nxt; nxt = nn; has_next = has_nn; cB = nB; ct0 = nt0; ct1 = nt1; nt0 = nn0; nt1 = nn1; cA = nA; ++ui;
        if (wr == 1) PG8_BAR;
    }
    PG8_WAIT_V(0);
    PG8_BAR;
    if constexpr (Epi::RIDER) {
        for (int u2 = ui + 1; ; ++u2) { const int q = (u2 * (int)gridDim.x + (int)blockIdx.x) * 8 + wid; if (q >= W2_PASSES) break;
            f32x4 rv[2][4]; w2_pass_load(rv, E.w2, q, lane); w2_pass_emit(rv, E.w2t, q, lds + W2SCR_OFF + wid * W2SCR_WAVE, lane, WSCALE); }
    }
#undef PG8_SA
#undef PG8_SB
#undef PG8_STAGE
#undef PG8_STAGEA
#undef PG8_LDA
#undef PG8_LDB
#undef PG8_MMA
#undef PG8_CAT
#undef PG8_WAIT_V
#undef PG8_WAIT_L
#undef PG8_BAR
#undef PG8_SCHED
#undef PG8_TOK2
#undef PG8_KBODY
}
}

#define XB_TMO      128
#define XB_XCNT(j)  (256  + 64 * (j))
#define XB_XSUB(j)  (1280 + 64 * (j))
#define XB_XGEN(j)  (2304 + 64 * (j))
#define XB_TOP      3328
#define XB_TOPGEN   3392
#define XCD_BAR_WORDS 3456
#define XB_SPIN_CAP (1u << 18)
__device__ __forceinline__ unsigned xb_ld(unsigned* p)              { return __hip_atomic_load(p, __ATOMIC_RELAXED, __HIP_MEMORY_SCOPE_AGENT); }
__device__ __forceinline__ unsigned xb_add(unsigned* p, unsigned v) { return __hip_atomic_fetch_add(p, v, __ATOMIC_RELAXED, __HIP_MEMORY_SCOPE_AGENT); }
__device__ __forceinline__ unsigned xb_xcc_id() { return (unsigned)__builtin_amdgcn_s_getreg((3 << 11) | 20) & 0xFu; }
#define XB_SPIN(cond, bar) do { unsigned _sp = 0; while (cond) { __builtin_amdgcn_s_sleep(1); \
    if ((++_sp & 255u) == 0u) { if (xb_ld(&(bar)[XB_TMO])) break; if (_sp > XB_SPIN_CAP) { atomicAdd(&(bar)[XB_TMO], 1u); break; } } } } while (0)
struct XcdBarrier { unsigned* bar; unsigned x; volatile LAS unsigned* st; };
__device__ __forceinline__ XcdBarrier xcd_barrier_post(unsigned* bar, volatile LAS unsigned* st) {
    XcdBarrier b; b.bar = bar; b.x = xb_xcc_id(); b.st = st;
    if (threadIdx.x == 0) (void)xb_add(&bar[XB_XCNT(b.x)], 1u);
    return b;
}
__device__ __forceinline__ void xcd_barrier_complete(unsigned* bar, unsigned x, unsigned& nloc, unsigned& nx) {
    const unsigned G = gridDim.x * gridDim.y * gridDim.z;
    unsigned sum, cnt, mine, sp = 0u;
    for (;;) {
        sum = 0u; cnt = 0u; mine = 0u;
#pragma unroll
        for (unsigned j = 0; j < 16; ++j) { const unsigned c = xb_ld(&bar[XB_XCNT(j)]); sum += c; cnt += (c > 0u) ? 1u : 0u; mine = (j == x) ? c : mine; }
        if (sum == G) break;
        __builtin_amdgcn_s_sleep(1);
        if ((++sp & 255u) == 0u) { if (xb_ld(&bar[XB_TMO])) break; if (sp > XB_SPIN_CAP) { atomicAdd(&bar[XB_TMO], 1u); break; } }
    }
    nloc = mine > 0u ? mine : 1u; nx = cnt > 0u ? cnt : 1u;
}
__device__ __forceinline__ void xcd_barrier(const XcdBarrier& b) {
    asm volatile("s_waitcnt vmcnt(0)" ::: "memory");
    __syncthreads();
    if (threadIdx.x == 0) {
        unsigned* bar = b.bar;
        __builtin_amdgcn_s_waitcnt(0);
        unsigned nloc = b.st[0], nx = b.st[1];
        if (nloc == 0u) { xcd_barrier_complete(bar, b.x, nloc, nx); b.st[0] = nloc; b.st[1] = nx; }
        const unsigned old = xb_add(&bar[XB_XSUB(b.x)], 1u);
        const unsigned gen = old / nloc;
        if (old + 1u == (gen + 1u) * nloc) {
            __builtin_amdgcn_fence(__ATOMIC_RELEASE, "agent");
            asm volatile("s_waitcnt vmcnt(0)" ::: "memory");
            const unsigned og = xb_add(&bar[XB_TOP], 1u);
            const unsigned tg = og / nx;
            if (og + 1u == (tg + 1u) * nx) xb_add(&bar[XB_TOPGEN], 1u);
            else XB_SPIN(xb_ld(&bar[XB_TOPGEN]) == tg, bar);
            __builtin_amdgcn_fence(__ATOMIC_ACQUIRE, "agent");
            xb_add(&bar[XB_XGEN(b.x)], 1u);
            asm volatile("s_waitcnt vmcnt(0)" ::: "memory");
        } else {
            XB_SPIN(xb_ld(&bar[XB_XGEN(b.x)]) == gen, bar);
            __builtin_amdgcn_fence(__ATOMIC_ACQUIRE, "agent");
            asm volatile("s_waitcnt vmcnt(0)" ::: "memory");
        }
    }
    __syncthreads();
}

constexpr int NWAVES = 8, NTHR = 512;
struct Args { const float* in[29]; float* out; unsigned char* ws; int ph_lo, ph_hi; };
static_assert(sizeof(Args) == 31 * 8 + 8, "Args has no padding");
enum { I_X = 0, I_MEM, I_GMIX, I_WIN, I_CONVW, I_CONVB, I_WA, I_BA, I_WX, I_BX, I_LAM, I_QN, I_KN, I_SINK, I_GMEM, I_WMKV, I_QNM, I_KNM, I_GOL, I_GOS, I_GOM, I_WOUT, I_GFFN, I_WR, I_BR, I_W1, I_B1, I_W2, I_B2 };

struct Frame {
    LAS unsigned char* lds;
    int tid, lane, wave, G, bid;
    float* out; unsigned char* ws;
};
struct InTab { const LAS unsigned* t;
    __device__ __forceinline__ const float* operator[](int i) const { const unsigned lo = __builtin_amdgcn_readfirstlane(t[2 * i]), hi = __builtin_amdgcn_readfirstlane(t[2 * i + 1]); return (const float*)(const GAS float*)(((unsigned long long)hi << 32) | lo); } };
__device__ __forceinline__ float wave_sum(float v) {
#pragma unroll
    for (int o = 1; o < 64; o <<= 1) v += __shfl_xor(v, o);
    return v;
}

template <int MODE>
__device__ __forceinline__ void p0_transpose_item(const float* W, int N, int Kp, const float* kscale, bf16* WT, LAS float* scr, int kb, int nb, int lane) {
    const int k0 = 64 * kb, n0 = 32 * nb;
    float v[32];
#pragma unroll
    for (int i = 0; i < 32; ++i) { const int kk = 2 * i + (lane >> 5); v[i] = W[(size_t)(k0 + kk) * N + n0 + (lane & 31)]; }
#pragma unroll
    for (int i = 0; i < 32; ++i) { const int kk = 2 * i + (lane >> 5); scr[kk * 33 + (lane & 31)] = kscale ? v[i] * kscale[k0 + kk] : v[i]; }
    LDS_WAIT(); asm volatile("" ::: "memory");
    const int c = lane & 7;
#pragma unroll
    for (int j = 0; j < 4; ++j) { const int n = (lane >> 3) + 8 * j; const LAS float* s = scr + (8 * c) * 33 + n;
        u32x4 o; o.x = pk2(s[0 * 33], s[1 * 33]); o.y = pk2(s[2 * 33], s[3 * 33]); o.z = pk2(s[4 * 33], s[5 * 33]); o.w = pk2(s[6 * 33], s[7 * 33]);
        int nn = n0 + n; if (MODE == 1) { const int a = nn >> 1, s1 = nn & 1; nn = 256 * (a >> 7) + 128 * s1 + (a & 127); }
        *(GAS u32x4*)(WT + (size_t)nn * Kp + k0 + 8 * c) = o; }
    LDS_WAIT(); asm volatile("" ::: "memory");
}
__device__ __forceinline__ void p0_prologue(Frame& F) {
    const InTab in{(const LAS unsigned*)(F.lds + PTAB_OFF)}; unsigned char* ws = F.ws;
    {
        LAS float* XN = (LAS float*)F.lds;
        LAS float* PART = (LAS float*)(F.lds + 32768);
        bf16* KM = (bf16*)(ws + SM_KM); bf16* VM = (bf16*)(ws + SM_VM); bf16* VMT = (bf16*)(ws + SM_VMT);
        for (int unit = F.bid; unit < 256; unit += F.G) {
            const int rg = unit >> 3, cs = unit & 7;
            __syncthreads();
            { const int m = 8 * rg + F.wave; const GAS f32x4* mr = (const GAS f32x4*)(in[I_MEM] + (size_t)m * D) + F.lane; f32x4 v[4]; float sq = 0.f;
#pragma unroll
              for (int j = 0; j < 4; ++j) { v[j] = mr[64 * j]; sq += (v[j].x * v[j].x + v[j].y * v[j].y) + (v[j].z * v[j].z + v[j].w * v[j].w); }
              const float rs = 1.0f / sqrtf(wave_sum(sq) * (1.0f / D) + EPS);
#pragma unroll
              for (int j = 0; j < 4; ++j) { const f32x4 g = *(const f32x4*)(in[I_GMEM] + 256 * j + 4 * F.lane); *(LAS f32x4*)(XN + F.wave * 1024 + 256 * j + 4 * F.lane) = v[j] * rs * g; } }
            __syncthreads();
            const int col = F.lane, kg = F.wave;
            float a[8];
#pragma unroll
            for (int r = 0; r < 8; ++r) a[r] = 0.f;
            const float* wp = in[I_WMKV] + (size_t)(128 * kg) * 512 + 64 * cs + col;
#pragma unroll 4
            for (int k = 0; k < 128; k += 4) {
                const float w0 = wp[(size_t)k * 512], w1 = wp[(size_t)(k + 1) * 512], w2 = wp[(size_t)(k + 2) * 512], w3 = wp[(size_t)(k + 3) * 512];
#pragma unroll
                for (int r = 0; r < 8; ++r) { const f32x4 x = *(const LAS f32x4*)(XN + r * 1024 + 128 * kg + k); a[r] += x.x * w0 + x.y * w1 + x.z * w2 + x.w * w3; }
            }
#pragma unroll
            for (int r = 0; r < 8; ++r) PART[(kg * 8 + r) * 64 + col] = a[r];
            __syncthreads();
            { const int r = F.wave, m = 8 * rg + r; float v = 0.f;
#pragma unroll
              for (int g = 0; g < 8; ++g) v += PART[(g * 8 + r) * 64 + col];
              if (cs < 4) { const float rk = 1.0f / sqrtf(wave_sum(v * v) * (1.0f / 64.0f) + EPS); KM[((size_t)cs * MEM_LEN + m) * 64 + col] = (bf16)f2bf(v * rk * in[I_KNM][col]); }
              else { const int h = cs - 4; VM[((size_t)h * MEM_LEN + m) * 64 + col] = (bf16)f2bf(v); const int kk = m & 31; VMT[((size_t)h * 64 + col) * MEM_LEN + (m & ~31) + 8 * ((kk >> 2) & 3) + 4 * (kk >> 4) + (kk & 3)] = (bf16)f2bf(v); } }
        }
        __syncthreads();
    }
    LAS float* scr = (LAS float*)(F.lds + F.wave * 16384);
    const int gw = F.bid * NWAVES + F.wave, NGW = F.G * NWAVES;
    constexpr int I_IN = 16 * 52, I_OUT = 16 * 32, I_W1E = 8 * 64, I_W2E = 8 * 32, I_LRU = 24;
    constexpr int NITEMS = I_IN + I_OUT + 32 * I_W1E + 32 * I_W2E + I_LRU;
    for (int it = gw; it < NITEMS - 32 * I_W1E - 32 * I_W2E; it += NGW) {
        int r = it;
        if (r < I_IN) { p0_transpose_item<0>(in[I_WIN], D_IN, D, in[I_GMIX], (bf16*)(ws + WS_WIN), scr, r / 52, r % 52, F.lane); continue; } r -= I_IN;
        if (r < I_OUT) { p0_transpose_item<0>(in[I_WOUT], D, D, nullptr, (bf16*)(ws + WS_WOUT), scr, r / 32, r % 32, F.lane); continue; } r -= I_OUT;
        { const int mat = r / 12, q = r % 12, h = q / 2, nb = q % 2;
          p0_transpose_item<0>(in[mat ? I_WX : I_WA] + (size_t)h * 4096, 64, 64, nullptr, (bf16*)(ws + (mat ? SM_WXT : SM_WAT)) + (size_t)h * 4096, scr, 0, nb, F.lane); }
    }
    constexpr int cb0 = (NITEMS - 32 * I_W1E - 32 * I_W2E + NWAVES - 1) / NWAVES;
    int gt = F.bid * NTHR + F.tid, NGT = F.G * NTHR;
    if (F.G >= cb0 + 32) { NGT = (F.G - cb0) * NTHR; gt = F.bid >= cb0 ? (F.bid - cb0) * NTHR + F.tid : (1 << 30); }
    { u32x4* z = (u32x4*)((bf16*)(ws + WS_WIN) + (size_t)D_IN * D); for (int i = gt; i < (D_INP - D_IN) * D * 2 / 16; i += NGT) z[i] = (u32x4){0u, 0u, 0u, 0u}; }
    { float* b1p = (float*)(ws + SM_B1P); for (int i = gt; i < NE * FF2; i += NGT) { const int e = i / FF2, np = i % FF2; const int pn = np >> 8, s1 = (np >> 7) & 1, xx = np & 127; b1p[i] = in[I_B1][(size_t)e * FF2 + 2 * (128 * pn + xx) + s1]; } }
    { bf16* wrh = (bf16*)(ws + SM_WRH); bf16* wrl = (bf16*)(ws + SM_WRL);
      for (int i = gt; i < NE * D; i += NGT) { const int e = i >> 10, k = i & 1023; const float w = in[I_WR][(size_t)k * NE + e] * in[I_GFFN][k]; const unsigned hi = f2bf(w); wrh[i] = (bf16)hi; wrl[i] = (bf16)f2bf(w - __uint_as_float(hi << 16)); } }
    for (int m = 2 * gw; m < S; m += 2 * NGW) {
        const GAS f32x4* xr = (const GAS f32x4*)(in[I_X] + (size_t)m * D) + F.lane;
        f32x4 v[8]; float s2 = 0.f, s3 = 0.f;
#pragma unroll
        for (int j = 0; j < 8; ++j) v[j] = __builtin_nontemporal_load(xr + 64 * j);
#pragma unroll
        for (int j = 0; j < 4; ++j) { s2 += (v[j].x * v[j].x + v[j].y * v[j].y) + (v[j].z * v[j].z + v[j].w * v[j].w); s3 += (v[4 + j].x * v[4 + j].x + v[4 + j].y * v[4 + j].y) + (v[4 + j].z * v[4 + j].z + v[4 + j].w * v[4 + j].w); }
        s2 = wave_sum(s2); s3 = wave_sum(s3);
        if (F.lane == 0) { ((float*)(ws + SM_RSTD1))[m] = 1.0f / sqrtf(s2 * (1.0f / D) + EPS); ((float*)(ws + SM_RSTD1))[m + 1] = 1.0f / sqrtf(s3 * (1.0f / D) + EPS); }
        GAS unsigned long long* o8 = (GAS unsigned long long*)((bf16*)(ws + WS_XB) + (size_t)m * D) + F.lane;
#pragma unroll
        for (int j = 0; j < 8; ++j) o8[64 * j] = (unsigned long long)pk2(v[j].x, v[j].y) | ((unsigned long long)pk2(v[j].z, v[j].w) << 32);
    }
}

__device__ __forceinline__ float sigmoidf_(float x) { return __builtin_amdgcn_rcpf(1.0f + __builtin_amdgcn_exp2f(-1.4426950408889634f * x)); }
__device__ __forceinline__ float gelu_tanh(float x) { const float u = 0.7978845608028654f * (x + 0.044715f * x * x * x); return x * sigmoidf_(2.0f * u); }
__device__ __forceinline__ float rsq_(float x) { return __builtin_amdgcn_rsqf(x); }
__device__ __forceinline__ float sqrt_negexpm1_sq(float x, float ex) { const float ser = -x * (1.0f + x * (0.5f + x * (0.16666667f + x * 0.041666668f)));
    return __builtin_amdgcn_sqrtf(fmaxf(x > -0.125f ? ser : 1.0f - ex, 0.f)); }
__device__ __forceinline__ float sqrt_negexpm1(float x) { const float ser = -x * (1.0f + x * (0.5f + x * (0.16666667f + x * 0.041666668f))); const float dir = 1.0f - __builtin_amdgcn_exp2f(1.4426950408889634f * x);
    return __builtin_amdgcn_sqrtf(fmaxf(x > -0.125f ? ser : dir, 0.f)); }

__device__ __forceinline__ f32x4 mfma16(bf16x8 a, bf16x8 b, f32x4 c) { return __builtin_amdgcn_mfma_f32_16x16x32_bf16(a, b, c, 0, 0, 0); }
__device__ __forceinline__ bf16x8 frag_from(u32x4 w) { return __builtin_bit_cast(bf16x8, w); }
constexpr float LOG2E = 1.4426950408889634f;
__device__ __forceinline__ void q_frags(const bf16* U, int t, int col0, const float* gain, int g, bf16x8& q0, bf16x8& q1) {
    const bf16* qp = U + (size_t)t * D_INP + col0 + 8 * g;
    const u32x4 w0 = *(const u32x4*)qp, w1 = *(const u32x4*)(qp + 32);
    float f[16] = {bflo(w0.x), bfhi(w0.x), bflo(w0.y), bfhi(w0.y), bflo(w0.z), bfhi(w0.z), bflo(w0.w), bfhi(w0.w), bflo(w1.x), bfhi(w1.x), bflo(w1.y), bfhi(w1.y), bflo(w1.z), bfhi(w1.z), bflo(w1.w), bfhi(w1.w)};
    float sq = 0.f;
#pragma unroll
    for (int j = 0; j < 16; ++j) sq += f[j] * f[j];
    sq += __shfl_xor(sq, 16); sq += __shfl_xor(sq, 32);
    const float rs = 0.125f * LOG2E * rsq_(sq * (1.0f / 64.0f) + EPS);
    const f32x4 ga = *(const f32x4*)(gain + 8 * g), gb = *(const f32x4*)(gain + 8 * g + 4), gc = *(const f32x4*)(gain + 32 + 8 * g), gd = *(const f32x4*)(gain + 32 + 8 * g + 4);
    u32x4 o0, o1;
    o0.x = pk2(f[0] * rs * ga.x, f[1] * rs * ga.y); o0.y = pk2(f[2] * rs * ga.z, f[3] * rs * ga.w); o0.z = pk2(f[4] * rs * gb.x, f[5] * rs * gb.y); o0.w = pk2(f[6] * rs * gb.z, f[7] * rs * gb.w);
    o1.x = pk2(f[8] * rs * gc.x, f[9] * rs * gc.y); o1.y = pk2(f[10] * rs * gc.z, f[11] * rs * gc.w); o1.z = pk2(f[12] * rs * gd.x, f[13] * rs * gd.y); o1.w = pk2(f[14] * rs * gd.z, f[15] * rs * gd.w);
    q0 = frag_from(o0); q1 = frag_from(o1);
}

typedef short v4i16_t __attribute__((ext_vector_type(4)));
__device__ __forceinline__ u32x2 tr16(const LAS bf16* p) { return __builtin_bit_cast(u32x2, __builtin_amdgcn_ds_read_tr16_b64_v4i16((LAS v4i16_t*)p)); }
__device__ __forceinline__ void swa_tile_mfma(Frame& F, int b, pg8::W1Rider& R) {
    const InTab in{(const LAS unsigned*)(F.lds + PTAB_OFF)}; unsigned char* ws = F.ws;
    const bf16* U = (const bf16*)(ws + WS_U);
    constexpr int KP = 72, VR = 208;
    LAS bf16* Ks = (LAS bf16*)F.lds;
    LAS bf16* VT = Ks + 2 * 192 * KP;
    LAS float* SSQ = (LAS float*)(F.lds + 115200);
    const int t0 = 64 * b, g = F.lane >> 4, c16 = F.lane & 15;
    bf16x8 qf[3][2];
#pragma unroll
    for (int pi = 0; pi < 3; ++pi) { const int p = (F.tid >> 6) + 8 * pi, head = p >> 2, qt = p & 3; q_frags(U, t0 + 16 * qt + c16, OFF_Q + head * 64, in[I_QN], g, qf[pi][0], qf[pi][1]); }
    float sinkv[3];
#pragma unroll
    for (int pi = 0; pi < 3; ++pi) sinkv[pi] = in[I_SINK][((F.tid >> 6) + 8 * pi) >> 2];
    __syncthreads();
    {
        const int dg = F.tid & 7; u32x4 kvr[6], vvr[6];
#pragma unroll
        for (int i = 0; i < 6; ++i) { const int key = (F.tid >> 3) + 64 * (i % 3), kvh = i / 3, pos = t0 - 128 + key, pc = pos < 0 ? 0 : pos;
            kvr[i] = *(const u32x4*)(U + (size_t)pc * D_INP + OFF_K + kvh * 64 + dg * 8); vvr[i] = *(const u32x4*)(U + (size_t)pc * D_INP + OFF_V + kvh * 64 + dg * 8); }
        const f32x4 kn0 = *(const f32x4*)(in[I_KN] + dg * 8), kn1 = *(const f32x4*)(in[I_KN] + dg * 8 + 4);
        R.issue(F.lane);
#pragma unroll
        for (int i = 0; i < 6; ++i) { const int key = (F.tid >> 3) + 64 * (i % 3), kvh = i / 3, pos = t0 - 128 + key;
            u32x4 kv = kvr[i], vv = vvr[i]; if (pos < 0) { kv = (u32x4){0u, 0u, 0u, 0u}; vv = kv; }
            float f[8] = {bflo(kv.x), bfhi(kv.x), bflo(kv.y), bfhi(kv.y), bflo(kv.z), bfhi(kv.z), bflo(kv.w), bfhi(kv.w)};
            float sq = 0.f;
#pragma unroll
            for (int j = 0; j < 8; ++j) sq += f[j] * f[j];
            sq += __shfl_xor(sq, 1); sq += __shfl_xor(sq, 2); sq += __shfl_xor(sq, 4);
            const float rs = rsq_(sq * (1.0f / 64.0f) + EPS);
            u32x4 o; o.x = pk2(f[0] * rs * kn0.x, f[1] * rs * kn0.y); o.y = pk2(f[2] * rs * kn0.z, f[3] * rs * kn0.w); o.z = pk2(f[4] * rs * kn1.x, f[5] * rs * kn1.y); o.w = pk2(f[6] * rs * kn1.z, f[7] * rs * kn1.w);
            *(LAS u32x4*)(Ks + (kvh * 192 + key) * KP + dg * 8) = o;
            *(LAS u32x4*)(VT + (kvh * VR + key) * KP + dg * 8) = vv; }
    }
    if (F.tid < 2 * 16 * 8) { const int kvh = F.tid >> 7, row = (F.tid >> 3) & 15, c = F.tid & 7; *(LAS u32x4*)(VT + (kvh * VR + 192 + row) * KP + c * 8) = (u32x4){0u, 0u, 0u, 0u}; }

    __syncthreads();
    f32x4 rvx[2][4]; int rqx = -1; if (R.q < R.qend) { rqx = R.q; R.q += R.qstep; pg8::wq_pass_load<true>(rvx, R.w1, rqx, F.lane); }
    f32x4 oacc[3][4];
#pragma unroll
    for (int pi = 0; pi < 3; ++pi) {
        const int p = (F.tid >> 6) + 8 * pi, head = p >> 2, qt = p & 3, kvh = head / 3;
        const bf16x8 q0 = qf[pi][0], q1 = qf[pi][1];
        f32x4 st[10];
#pragma unroll
        for (int i = 0; i < 9; ++i) { const LAS bf16* kr = Ks + (kvh * 192 + 16 * (qt + i) + c16) * KP + 8 * g;
            f32x4 a = (f32x4){0.f, 0.f, 0.f, 0.f}; a = mfma16(*(const LAS bf16x8*)kr, q0, a); a = mfma16(*(const LAS bf16x8*)(kr + 32), q1, a); st[i] = a; }
        const float sink = sinkv[pi] * LOG2E; float mx = sink;
#pragma unroll
        for (int i = 0; i < 9; ++i)
#pragma unroll
            for (int r = 0; r < 4; ++r) { const int koff = 4 * g + r; bool ok = (t0 - 128 + 16 * (qt + i) + koff) >= 0; if (i == 0) ok = ok && (koff > c16); if (i == 8) ok = ok && (koff <= c16);
                st[i][r] = ok ? st[i][r] : -1.0e30f; mx = fmaxf(mx, st[i][r]); }
        mx = fmaxf(mx, __shfl_xor(mx, 16)); mx = fmaxf(mx, __shfl_xor(mx, 32));
        float l = 0.f;
#pragma unroll
        for (int i = 0; i < 9; ++i)
#pragma unroll
            for (int r = 0; r < 4; ++r) { st[i][r] = __builtin_amdgcn_exp2f(st[i][r] - mx); l += st[i][r]; }
        st[9] = (f32x4){0.f, 0.f, 0.f, 0.f};
        l += __shfl_xor(l, 16); l += __shfl_xor(l, 32); l += __builtin_amdgcn_exp2f(sink - mx);
        f32x4 ot[4];
#pragma unroll
        for (int dt = 0; dt < 4; ++dt) ot[dt] = (f32x4){0.f, 0.f, 0.f, 0.f};
#pragma unroll
        for (int u = 0; u < 5; ++u) {
            u32x4 pw; pw.x = pk2(st[2 * u][0], st[2 * u][1]); pw.y = pk2(st[2 * u][2], st[2 * u][3]); pw.z = pk2(st[2 * u + 1][0], st[2 * u + 1][1]); pw.w = pk2(st[2 * u + 1][2], st[2 * u + 1][3]);
            const bf16x8 pf = frag_from(pw);
#pragma unroll
            for (int dt = 0; dt < 4; ++dt) { const LAS bf16* vr = VT + (kvh * VR + 16 * (qt + 2 * u) + 4 * g + (c16 >> 2)) * KP + 16 * dt + 4 * (c16 & 3);
                const u32x2 lo = tr16(vr), hi = tr16(vr + 16 * KP);
                ot[dt] = mfma16(frag_from((u32x4){lo.x, lo.y, hi.x, hi.y}), pf, ot[dt]); }
        }
        const float il = __builtin_amdgcn_rcpf(l); float sq = 0.f;
#pragma unroll
        for (int dt = 0; dt < 4; ++dt) { oacc[pi][dt] = ot[dt] * il; sq += (oacc[pi][dt][0] * oacc[pi][dt][0] + oacc[pi][dt][1] * oacc[pi][dt][1]) + (oacc[pi][dt][2] * oacc[pi][dt][2] + oacc[pi][dt][3] * oacc[pi][dt][3]); }
        sq += __shfl_xor(sq, 16); sq += __shfl_xor(sq, 32);
        if (g == 0) SSQ[head * 64 + 16 * qt + c16] = sq;
    }
    f32x4 gsw[3][4];
#pragma unroll
    for (int pi = 0; pi < 3; ++pi)
#pragma unroll
        for (int dt = 0; dt < 4; ++dt) gsw[pi][dt] = *(const f32x4*)(in[I_GOS] + (((F.tid >> 6) + 8 * pi) >> 2) * 64 + 4 * g + 16 * dt);
    __syncthreads();
#pragma unroll
    for (int pi = 0; pi < 3; ++pi) {
        const int p = (F.tid >> 6) + 8 * pi, head = p >> 2, qt = p & 3; const int ql = 16 * qt + c16;
        const float tot = (SSQ[ql] + SSQ[64 + ql]) + (SSQ[128 + ql] + SSQ[192 + ql]) + (SSQ[256 + ql] + SSQ[320 + ql]);
        const float rs = rsq_(tot * (1.0f / 384.0f) + EPS);
        bf16* yo = (bf16*)(ws + WS_Y) + (size_t)(t0 + ql) * D + 384 + head * 64 + 4 * g;
#pragma unroll
        for (int dt = 0; dt < 4; ++dt) { const f32x4 gv = gsw[pi][dt]; const f32x4 o = oacc[pi][dt] * rs * gv; u32x2 w; w.x = pk2(o[0], o[1]); w.y = pk2(o[2], o[3]); *(u32x2*)(yo + 16 * dt) = w; }
    }
    R.retire(F.lane); if (rqx >= 0) pg8::wq_pass_emit<true>(rvx, R.w1t, rqx, R.scr, F.lane, WSCALE);
    __syncthreads();
}

__device__ __forceinline__ void mem_tile_mfma(Frame& F, int b, pg8::W1Rider& R) {
    const InTab in{(const LAS unsigned*)(F.lds + PTAB_OFF)}; unsigned char* ws = F.ws;
    const bf16* U = (const bf16*)(ws + WS_U);
    LAS unsigned char* KV = F.lds;
    LAS float* SSQ = (LAS float*)(F.lds + RING_BYTES + 5120);
    const int t0 = 64 * b, g = F.lane >> 4, c16 = F.lane & 15, head = F.tid >> 7, wq = (F.tid >> 6) & 1;

    bf16x8 q[2][2];
#pragma unroll
    for (int qi = 0; qi < 2; ++qi) q_frags(U, t0 + 16 * (2 * wq + qi) + c16, OFF_QM + head * 64, in[I_QNM], g, q[qi][0], q[qi][1]);
    __syncthreads();
    { const u32x4* src = (const u32x4*)(ws + SM_KM);
      u32x4 sv[16];
#pragma unroll
      for (int j = 0; j < 16; ++j) sv[j] = src[F.tid + 512 * j];
      R.issue(F.lane);
#pragma unroll
      for (int j = 0; j < 16; ++j) { const int idx = F.tid + 512 * j, c = idx & 7, row = idx >> 3; *(LAS u32x4*)(KV + (row * 8 + (c ^ (row & 7))) * 16) = sv[j]; } }
    R.retire(F.lane);
    __syncthreads();
    f32x4 st[2][16];
#pragma unroll
    for (int kt = 0; kt < 16; ++kt) { const int row = head * 256 + 16 * kt + c16;
        const bf16x8 k0 = *(const LAS bf16x8*)(KV + (row * 8 + (g ^ (row & 7))) * 16), k1 = *(const LAS bf16x8*)(KV + (row * 8 + ((4 + g) ^ (row & 7))) * 16);
#pragma unroll
        for (int qi = 0; qi < 2; ++qi) { f32x4 a = (f32x4){0.f, 0.f, 0.f, 0.f}; a = mfma16(k0, q[qi][0], a); a = mfma16(k1, q[qi][1], a); st[qi][kt] = a; } }
    u32x4 pf[2][8]; float il[2];
#pragma unroll
    for (int qi = 0; qi < 2; ++qi) { float mx = -1.0e30f;
#pragma unroll
        for (int kt = 0; kt < 16; ++kt) mx = fmaxf(fmaxf(mx, fmaxf(st[qi][kt][0], st[qi][kt][1])), fmaxf(st[qi][kt][2], st[qi][kt][3]));
        mx = fmaxf(mx, __shfl_xor(mx, 16)); mx = fmaxf(mx, __shfl_xor(mx, 32));
        float l = 0.f;
#pragma unroll
        for (int kt = 0; kt < 16; ++kt)
#pragma unroll
            for (int r = 0; r < 4; ++r) { st[qi][kt][r] = __builtin_amdgcn_exp2f(st[qi][kt][r] - mx); l += st[qi][kt][r]; }
        l += __shfl_xor(l, 16); l += __shfl_xor(l, 32); il[qi] = __builtin_amdgcn_rcpf(l);
#pragma unroll
        for (int u = 0; u < 8; ++u) { pf[qi][u].x = pk2(st[qi][2 * u][0], st[qi][2 * u][1]); pf[qi][u].y = pk2(st[qi][2 * u][2], st[qi][2 * u][3]); pf[qi][u].z = pk2(st[qi][2 * u + 1][0], st[qi][2 * u + 1][1]); pf[qi][u].w = pk2(st[qi][2 * u + 1][2], st[qi][2 * u + 1][3]); } }
    R.issue(F.lane);
    __syncthreads();
    { const u32x4* src = (const u32x4*)(ws + SM_VMT);
#pragma unroll 8
      for (int j = 0; j < 16; ++j) { const int idx = F.tid + 512 * j, c = idx & 31, row = idx >> 5; *(LAS u32x4*)(KV + (row * 32 + (c ^ (row & 7))) * 16) = src[idx]; } }
    R.retire(F.lane);
    __syncthreads();
    R.issue(F.lane);
    f32x4 ot[2][4];
#pragma unroll
    for (int qi = 0; qi < 2; ++qi)
#pragma unroll
        for (int dt = 0; dt < 4; ++dt) ot[qi][dt] = (f32x4){0.f, 0.f, 0.f, 0.f};
#pragma unroll
    for (int u = 0; u < 8; ++u)
#pragma unroll
        for (int dt = 0; dt < 4; ++dt) { const int row = head * 64 + 16 * dt + c16; const bf16x8 vf = *(const LAS bf16x8*)(KV + (row * 32 + ((4 * u + g) ^ (row & 7))) * 16);
            ot[0][dt] = mfma16(vf, frag_from(pf[0][u]), ot[0][dt]); ot[1][dt] = mfma16(vf, frag_from(pf[1][u]), ot[1][dt]); }
#pragma unroll
    for (int qi = 0; qi < 2; ++qi) { float sq = 0.f;
#pragma unroll
        for (int dt = 0; dt < 4; ++dt) { ot[qi][dt] *= il[qi]; sq += (ot[qi][dt][0] * ot[qi][dt][0] + ot[qi][dt][1] * ot[qi][dt][1]) + (ot[qi][dt][2] * ot[qi][dt][2] + ot[qi][dt][3] * ot[qi][dt][3]); }
        sq += __shfl_xor(sq, 16); sq += __shfl_xor(sq, 32);
        if (g == 0) SSQ[head * 64 + 16 * (2 * wq + qi) + c16] = sq; }
    f32x4 gmv[4];
#pragma unroll
    for (int dt = 0; dt < 4; ++dt) gmv[dt] = *(const f32x4*)(in[I_GOM] + head * 64 + 4 * g + 16 * dt);
    __syncthreads();
#pragma unroll
    for (int qi = 0; qi < 2; ++qi) {
        const int ql = 16 * (2 * wq + qi) + c16;
        const float tot = (SSQ[ql] + SSQ[64 + ql]) + (SSQ[128 + ql] + SSQ[192 + ql]);
        const float rs = rsq_(tot * (1.0f / 256.0f) + EPS);
        bf16* yo = (bf16*)(ws + WS_Y) + (size_t)(t0 + ql) * D + 768 + head * 64 + 4 * g;
#pragma unroll
        for (int dt = 0; dt < 4; ++dt) { const f32x4 gv = gmv[dt]; const f32x4 o = ot[qi][dt] * rs * gv; u32x2 w; w.x = pk2(o[0], o[1]); w.y = pk2(o[2], o[3]); *(u32x2*)(yo + 16 * dt) = w; }
    }
    R.retire(F.lane);
    __syncthreads();
}

__device__ __forceinline__ void lru_tile_mfma(Frame& F, int b, int xq0, int xstep, int xqend) {
    const InTab in{(const LAS unsigned*)(F.lds + PTAB_OFF)}; unsigned char* ws = F.ws;
    const bf16* U = (const bf16*)(ws + WS_U);
    constexpr int UP = 72;
    LAS bf16* UL = (LAS bf16*)(F.lds + (F.tid >> 6) * 20480);
    LAS bf16* GL = UL + 68 * UP;
    float* AAGG = (float*)(ws + SM_AAGG); float* BAGG = (float*)(ws + SM_BAGG); unsigned* YP = (unsigned*)(ws + WS_YP);
    const int t0 = 64 * b, g = F.lane >> 4, c16 = F.lane & 15, hd = F.tid >> 6;
    __syncthreads();
    if (hd < 6) {
        {
            u32x4 uv[9], gv[8]; const int ch = F.lane & 7;
#pragma unroll
            for (int i = 0; i < 9; ++i) { const int row = min((F.lane >> 3) + 8 * i, 66), t = t0 - 3 + row; uv[i] = *(const u32x4*)(U + (size_t)(t < 0 ? 0 : t) * D_INP + OFF_LRU + hd * 64 + 8 * ch); }
#pragma unroll
            for (int i = 0; i < 8; ++i) { const int row = (F.lane >> 3) + 8 * i; gv[i] = *(const u32x4*)(U + (size_t)(t0 + row) * D_INP + OFF_GATE + hd * 64 + 8 * ch); }
#pragma unroll
            for (int i = 0; i < 9; ++i) { const int row = (F.lane >> 3) + 8 * i, t = t0 - 3 + row; u32x4 v = uv[i]; if (t < 0) v = (u32x4){0u, 0u, 0u, 0u};
                if (row < 67) *(LAS u32x4*)(UL + row * UP + 8 * ch) = v; }
#pragma unroll
            for (int i = 0; i < 8; ++i) { const int row = (F.lane >> 3) + 8 * i; *(LAS u32x4*)(GL + row * UP + 8 * ch) = gv[i]; }
        }
        LDS_WAIT(); asm volatile("" ::: "memory");
        bf16x8 xa[4][2];
#pragma unroll
        for (int s = 0; s < 2; ++s) {
            const int cbase = hd * 64 + 32 * s + 8 * g;
            float cw[4][8], cbv[8];
#pragma unroll
            for (int k = 0; k < 4; ++k) { const f32x4 a = *(const f32x4*)(in[I_CONVW] + k * 384 + cbase), bq = *(const f32x4*)(in[I_CONVW] + k * 384 + cbase + 4);
                cw[k][0] = a.x; cw[k][1] = a.y; cw[k][2] = a.z; cw[k][3] = a.w; cw[k][4] = bq.x; cw[k][5] = bq.y; cw[k][6] = bq.z; cw[k][7] = bq.w; }
            { const f32x4 a = *(const f32x4*)(in[I_CONVB] + cbase), bq = *(const f32x4*)(in[I_CONVB] + cbase + 4); cbv[0] = a.x; cbv[1] = a.y; cbv[2] = a.z; cbv[3] = a.w; cbv[4] = bq.x; cbv[5] = bq.y; cbv[6] = bq.z; cbv[7] = bq.w; }
#pragma unroll
            for (int tt = 0; tt < 4; ++tt) {
                float xv[8];
#pragma unroll
                for (int j = 0; j < 8; ++j) xv[j] = cbv[j];
#pragma unroll
                for (int k = 0; k < 4; ++k) { const u32x4 w = *(const LAS u32x4*)(UL + (16 * tt + c16 + k) * UP + 32 * s + 8 * g);
                    xv[0] += cw[k][0] * bflo(w.x); xv[1] += cw[k][1] * bfhi(w.x); xv[2] += cw[k][2] * bflo(w.y); xv[3] += cw[k][3] * bfhi(w.y);
                    xv[4] += cw[k][4] * bflo(w.z); xv[5] += cw[k][5] * bfhi(w.z); xv[6] += cw[k][6] * bflo(w.w); xv[7] += cw[k][7] * bfhi(w.w); }
                xa[tt][s] = frag_from((u32x4){pk2(xv[0], xv[1]), pk2(xv[2], xv[3]), pk2(xv[4], xv[5]), pk2(xv[6], xv[7])});
            }
        }
        const bf16* WaT = (const bf16*)(ws + SM_WAT) + (size_t)hd * 4096; const bf16* WxT = (const bf16*)(ws + SM_WXT) + (size_t)hd * 4096;
        bf16x8 wan[2], wxn[2];
#pragma unroll
        for (int s = 0; s < 2; ++s) { wan[s] = *(const bf16x8*)(WaT + c16 * 64 + 32 * s + 8 * g); wxn[s] = *(const bf16x8*)(WxT + c16 * 64 + 32 * s + 8 * g); }
        float lamv[4], bav[4], bxv[4];
#pragma unroll
        for (int ct = 0; ct < 4; ++ct) { const int c = hd * 64 + 16 * ct + c16; lamv[ct] = in[I_LAM][c]; bav[ct] = in[I_BA][c]; bxv[ct] = in[I_BX][c]; }
#pragma unroll 1
        for (int ct = 0; ct < 4; ++ct) {
            const int cp = 16 * ct + c16, c = hd * 64 + cp;
            const float lam_c = ct == 0 ? lamv[0] : ct == 1 ? lamv[1] : ct == 2 ? lamv[2] : lamv[3], ba = ct == 0 ? bav[0] : ct == 1 ? bav[1] : ct == 2 ? bav[2] : bav[3], bxb = ct == 0 ? bxv[0] : ct == 1 ? bxv[1] : ct == 2 ? bxv[2] : bxv[3];
            bf16x8 waf[2], wxf[2], idf[2];
#pragma unroll
            for (int s = 0; s < 2; ++s) { waf[s] = wan[s]; wxf[s] = wxn[s]; const int cpn = 16 * ((ct + 1) & 3) + c16; wan[s] = *(const bf16x8*)(WaT + cpn * 64 + 32 * s + 8 * g); wxn[s] = *(const bf16x8*)(WxT + cpn * 64 + 32 * s + 8 * g);
                u32x4 iw; const int kb = 32 * s + 8 * g;
                iw.x = (kb + 0 == cp ? 0x3F80u : 0u) | (kb + 1 == cp ? 0x3F800000u : 0u); iw.y = (kb + 2 == cp ? 0x3F80u : 0u) | (kb + 3 == cp ? 0x3F800000u : 0u);
                iw.z = (kb + 4 == cp ? 0x3F80u : 0u) | (kb + 5 == cp ? 0x3F800000u : 0u); iw.w = (kb + 6 == cp ? 0x3F80u : 0u) | (kb + 7 == cp ? 0x3F800000u : 0u); idf[s] = frag_from(iw); }
            f32x4 Da[4], Dx[4], Dc[4], yv[4];
#pragma unroll
            for (int tt = 0; tt < 4; ++tt) { f32x4 z = (f32x4){0.f, 0.f, 0.f, 0.f};
                Da[tt] = mfma16(xa[tt][1], waf[1], mfma16(xa[tt][0], waf[0], z)); Dx[tt] = mfma16(xa[tt][1], wxf[1], mfma16(xa[tt][0], wxf[0], z)); Dc[tt] = mfma16(xa[tt][1], idf[1], mfma16(xa[tt][0], idf[0], z));
                const f32x4 dg = mfma16(*(const LAS bf16x8*)(GL + (16 * tt + c16) * UP + 32 + 8 * g), idf[1], mfma16(*(const LAS bf16x8*)(GL + (16 * tt + c16) * UP + 8 * g), idf[0], z));
#pragma unroll
                for (int r = 0; r < 4; ++r) yv[tt][r] = gelu_tanh(dg[r]); }
            const float sp = log1pf(__expf(-lam_c));
#pragma unroll
            for (int tt = 0; tt < 4; ++tt)
#pragma unroll
                for (int r = 0; r < 4; ++r) { const float rr = sigmoidf_(Da[tt][r] + ba), ig = sigmoidf_(Dx[tt][r] + bxb); const float la = -8.0f * rr * sp;
                    const float a = __builtin_amdgcn_exp2f(LOG2E * la);
                    Da[tt][r] = a; Dx[tt][r] = sqrt_negexpm1_sq(2.0f * la, a * a) * ig * Dc[tt][r]; }
            float hs = 0.f, Atot = 1.f;
#pragma unroll
            for (int tt = 0; tt < 4; ++tt) {
                const f32x4 a = Da[tt], bb = Dx[tt];
                float Ai = (a[0] * a[1]) * (a[2] * a[3]), Bi = ((bb[0] * a[1] + bb[1]) * a[2] + bb[2]) * a[3] + bb[3];
                float Ap = __shfl_up(Ai, 16), Bp = __shfl_up(Bi, 16); if (g >= 1) { Bi = Ai * Bp + Bi; Ai = Ap * Ai; }
                Ap = __shfl_up(Ai, 32); Bp = __shfl_up(Bi, 32); if (g >= 2) { Bi = Ai * Bp + Bi; Ai = Ap * Ai; }
                float Ae = __shfl_up(Ai, 16), Be = __shfl_up(Bi, 16); if (g == 0) { Ae = 1.f; Be = 0.f; }
                float hl = Ae * hs + Be, pl = Atot * Ae;
#pragma unroll
                for (int r = 0; r < 4; ++r) { hl = a[r] * hl + bb[r]; pl *= a[r];
                    YP[(size_t)(t0 + 16 * tt + 4 * g + r) * 384 + c] = pk2(hl * yv[tt][r], pl * yv[tt][r]); }
                const float A3 = __shfl(Ai, c16 + 48), B3 = __shfl(Bi, c16 + 48); hs = A3 * hs + B3; Atot *= A3;
            }
            if (g == 0) { AAGG[(size_t)c * NTILE + b] = Atot; BAGG[(size_t)c * NTILE + b] = hs; }
            }
    } else if (xq0 < xqend) {
        pg8::W1Rider RX; RX.init_x(in[I_W1], ws + WS_W1, F.lds, F.wave, xq0, xstep, xqend); RX.drain3(F.lane);
    }
    __syncthreads();
}

__device__ __forceinline__ void lru_fix_tile(Frame& F, int b, pg8::W1Rider& R) {
    const InTab in{(const LAS unsigned*)(F.lds + PTAB_OFF)}; unsigned char* ws = F.ws;
    LAS float* CR = (LAS float*)F.lds;
    const int t0 = 64 * b;
    const int t = F.tid >> 3, part = F.tid & 7;
    const u32x4* yp = (const u32x4*)((const unsigned*)(ws + WS_YP) + (size_t)(t0 + t) * 384 + part * 48);
    u32x4 ypv[12];
#pragma unroll
    for (int j = 0; j < 12; ++j) ypv[j] = yp[j];
    float crv = 0.f; if (F.tid < 384) crv = ((const float*)(ws + SM_CARRY))[(size_t)F.tid * NTILE + b];
    R.issue(F.lane);
    __syncthreads();
    if (F.tid < 384) CR[F.tid] = crv;
    __syncthreads();
    float y[48]; float sq = 0.f;
#pragma unroll
    for (int j = 0; j < 12; ++j) { const u32x4 w = ypv[j]; const f32x4 cr = *(const LAS f32x4*)(CR + part * 48 + 4 * j);
        y[4 * j] = bflo(w.x) + bfhi(w.x) * cr.x; y[4 * j + 1] = bflo(w.y) + bfhi(w.y) * cr.y; y[4 * j + 2] = bflo(w.z) + bfhi(w.z) * cr.z; y[4 * j + 3] = bflo(w.w) + bfhi(w.w) * cr.w;
        sq += (y[4 * j] * y[4 * j] + y[4 * j + 1] * y[4 * j + 1]) + (y[4 * j + 2] * y[4 * j + 2] + y[4 * j + 3] * y[4 * j + 3]); }
    sq += __shfl_xor(sq, 1); sq += __shfl_xor(sq, 2); sq += __shfl_xor(sq, 4);
    const float rs = rsq_(sq * (1.0f / 384.0f) + EPS);
    const float* gp = in[I_GOL] + part * 48; bf16* yo = (bf16*)(ws + WS_Y) + (size_t)(t0 + t) * D + part * 48;
    f32x4 gl[12];
#pragma unroll
    for (int j = 0; j < 12; ++j) gl[j] = *(const f32x4*)(gp + 4 * j);
#pragma unroll
    for (int j = 0; j < 6; ++j) { const f32x4 ga = gl[2 * j], gb = gl[2 * j + 1];
        u32x4 w; w.x = pk2(y[8 * j] * rs * ga.x, y[8 * j + 1] * rs * ga.y); w.y = pk2(y[8 * j + 2] * rs * ga.z, y[8 * j + 3] * rs * ga.w); w.z = pk2(y[8 * j + 4] * rs * gb.x, y[8 * j + 5] * rs * gb.y); w.w = pk2(y[8 * j + 6] * rs * gb.z, y[8 * j + 7] * rs * gb.w);
        *(u32x4*)(yo + 8 * j) = w; }
    R.retire(F.lane);
    __syncthreads();
}

__device__ __forceinline__ void moe_tables(Frame& F) {
    LAS int* cnt = (LAS int*)(F.lds + TAB_OFF); LAS int* tile_start = cnt + 32; LAS int* row_start = tile_start + 33; LAS int* mt_expert = row_start + 32;
    gu32* ctl = (gu32*)(F.ws + WS_CTL);
    __syncthreads();
    if (F.tid < 32) {
        const int e = F.tid, c = (int)__hip_atomic_load((unsigned*)(ctl + CW_CNT + 64 * e), RLX_AGENT), n = (c + 255) >> 8;
        int incl = n;
#pragma unroll
        for (int d = 1; d < 32; d <<= 1) { const int t = __shfl_up(incl, d); if (e >= d) incl += t; }
        const int ts = min(incl - n, MAXMT);
        cnt[e] = c; tile_start[e] = ts; row_start[e] = ts * 256;
        for (int j = 0; j < n && ts + j < MAXMT; ++j) mt_expert[ts + j] = e;
        if (e == 31) tile_start[32] = min(incl, MAXMT);
    }
    __syncthreads();
}


__device__ __forceinline__ void carry_scan(Frame& F) {
    unsigned char* ws = F.ws;
    const float* AAGG = (const float*)(ws + SM_AAGG); const float* BAGG = (const float*)(ws + SM_BAGG); float* CARRY = (float*)(ws + SM_CARRY);
    for (int c = F.wave * F.G + F.bid; c < 384; c += 8 * F.G) {
        const f32x4 a4 = *(const f32x4*)(AAGG + (size_t)c * NTILE + 4 * F.lane), b4 = *(const f32x4*)(BAGG + (size_t)c * NTILE + 4 * F.lane);
        float A = (a4[0] * a4[1]) * (a4[2] * a4[3]), B = ((b4[0] * a4[1] + b4[1]) * a4[2] + b4[2]) * a4[3] + b4[3];
#pragma unroll
        for (int d = 1; d < 64; d <<= 1) { const float Ap = __shfl_up(A, d), Bp = __shfl_up(B, d); if (F.lane >= d) { B = A * Bp + B; A = A * Ap; } }
        float h = __shfl_up(B, 1); if (F.lane == 0) h = 0.f;
        f32x4 o; o[0] = h; h = a4[0] * h + b4[0]; o[1] = h; h = a4[1] * h + b4[1]; o[2] = h; h = a4[2] * h + b4[2]; o[3] = h;
        *(f32x4*)(CARRY + (size_t)c * NTILE + 4 * F.lane) = o;
    }
}

__device__ __forceinline__ void router_tile_mfma(Frame& F, int b, pg8::W1Rider& R) {
    const InTab in{(const LAS unsigned*)(F.lds + PTAB_OFF)}; unsigned char* ws = F.ws;
    const bf16* H = (const bf16*)(ws + WS_HBF);
    LAS float* LOGP = (LAS float*)F.lds;
    LAS float* RS = (LAS float*)(F.lds + 2 * 64 * 33 * 4);
    LAS int* hist = (LAS int*)(RS + 64);
    LAS int* base = hist + 32;
    gu32* ctl = (gu32*)(ws + WS_CTL);
    const int t0 = 64 * b, g = F.lane >> 4, c16 = F.lane & 15, tt = F.wave & 3, kh = F.wave >> 2;
    __syncthreads();
    if (F.tid < 64) { const float* sp = (const float*)(ws + SM_SSQP) + (size_t)(t0 + F.tid) * 16; float s = 0.f;
#pragma unroll
        for (int j = 0; j < 4; ++j) { const f32x4 v = *(const f32x4*)(sp + 4 * j); s += (v.x + v.y) + (v.z + v.w); }
        const float r = rsq_(s * (1.0f / D) + EPS); RS[F.tid] = r; ((float*)(ws + SM_RSTD2))[t0 + F.tid] = r; }
    if (F.tid < 32) hist[F.tid] = 0;
    f32x4 rva[2][4], rvb[2][4]; int rqa = -1, rqb = -1;
    R.issue3(rva, rvb, rqa, rqb, F.lane);
    const f32x4 brv = *(const f32x4*)(in[I_BR] + 4 * (F.lane & 7));
    f32x4 acc0 = (f32x4){0.f, 0.f, 0.f, 0.f}, acc1 = acc0;
    const bf16* hp = H + (size_t)(t0 + 16 * tt + c16) * D + 512 * kh + 8 * g;
    const bf16* wh = (const bf16*)(ws + SM_WRH) + (size_t)c16 * D + 512 * kh + 8 * g; const bf16* wl = (const bf16*)(ws + SM_WRL) + (size_t)c16 * D + 512 * kh + 8 * g;
#pragma unroll 4
    for (int ks = 0; ks < 16; ++ks) {
        const bf16x8 ahi = *(const bf16x8*)(hp + 32 * ks);
        const bf16x8 wh0 = *(const bf16x8*)(wh + 32 * ks), wh1 = *(const bf16x8*)(wh + 16 * D + 32 * ks), wl0 = *(const bf16x8*)(wl + 32 * ks), wl1 = *(const bf16x8*)(wl + 16 * D + 32 * ks);
        acc0 = mfma16(ahi, wh0, acc0); acc0 = mfma16(ahi, wl0, acc0);
        acc1 = mfma16(ahi, wh1, acc1); acc1 = mfma16(ahi, wl1, acc1);
    }
    R.retire3(rva, rvb, rqa, rqb, F.lane);
#pragma unroll
    for (int r = 0; r < 4; ++r) { LOGP[(kh * 64 + 16 * tt + 4 * g + r) * 33 + c16] = acc0[r]; LOGP[(kh * 64 + 16 * tt + 4 * g + r) * 33 + 16 + c16] = acc1[r]; }
    __syncthreads();
    const int s8 = F.lane & 7, tk = 8 * F.wave + (F.lane >> 3);
    float v[4]; int es[4]; float vs[4];
    { const LAS float* l0 = LOGP + tk * 33 + 4 * s8; const LAS float* l1 = l0 + 64 * 33; const float rs = RS[tk];
#pragma unroll
        for (int i = 0; i < 4; ++i) v[i] = (l0[i] + l1[i]) * rs + brv[i]; }
#pragma unroll
    for (int k = 0; k < 4; ++k) {
        float bv = v[0]; int gi = 4 * s8;
#pragma unroll
        for (int i = 1; i < 4; ++i) if (v[i] > bv) { bv = v[i]; gi = 4 * s8 + i; }
#pragma unroll
        for (int d = 1; d < 8; d <<= 1) { const float ov = __shfl_xor(bv, d); const int oi = __shfl_xor(gi, d); if (ov > bv || (ov == bv && oi < gi)) { bv = ov; gi = oi; } }
        vs[k] = bv; es[k] = gi;
#pragma unroll
        for (int i = 0; i < 4; ++i) if (gi == 4 * s8 + i) v[i] = -3.4e38f;
    }
    float gs[4]; { float sum = 0.f;
#pragma unroll
        for (int k = 0; k < 4; ++k) { gs[k] = __expf(vs[k] - vs[0]); sum += gs[k]; }
        const float inv = 1.0f / sum;
#pragma unroll
        for (int k = 0; k < 4; ++k) gs[k] *= inv; }
    const int my_e = s8 == 0 ? es[0] : s8 == 1 ? es[1] : s8 == 2 ? es[2] : es[3]; const float my_g = s8 == 0 ? gs[0] : s8 == 1 ? gs[1] : s8 == 2 ? gs[2] : gs[3];
    int lp = 0;
    if (s8 < 4) lp = atomicAdd((int*)&hist[my_e], 1);
    R.issue3(rva, rvb, rqa, rqb, F.lane);
    __syncthreads();
    if (F.tid < 32) { const int hcount = hist[F.tid]; base[F.tid] = hcount ? (int)__hip_atomic_fetch_add((unsigned*)(ctl + CW_CNT + 64 * F.tid), (unsigned)hcount, RLX_AGENT) : 0; }
    __syncthreads();
    if (s8 < 4) {
        const int t = t0 + tk; unsigned* list = (unsigned*)(ws + SM_LIST); float* rsl = (float*)(ws + SM_RSLIST);
        unsigned* ts = (unsigned*)(ws + SM_TOKSLOT); float* gt = (float*)(ws + SM_GATE);
        const int pos = base[my_e] + lp; list[(size_t)my_e * CAP + pos] = (unsigned)t; rsl[(size_t)my_e * CAP + pos] = RS[tk];
        ts[t * 4 + s8] = ((unsigned)my_e << 16) | (unsigned)pos; gt[t * 4 + s8] = my_g;
    }
    R.retire3(rva, rvb, rqa, rqb, F.lane);
    __syncthreads();
}

__device__ __forceinline__ f32x4 fp8x4_to_f32(unsigned w) { const f32x2 lo = __builtin_amdgcn_cvt_pk_f32_fp8((int)w, false), hi = __builtin_amdgcn_cvt_pk_f32_fp8((int)w, true); return (f32x4){lo.x, lo.y, hi.x, hi.y}; }
__device__ __forceinline__ void combine_tile2(Frame& F, int b) {
    unsigned char* ws = F.ws;
    const LAS int* row_start = (const LAS int*)(F.lds + TAB_OFF) + 32 + 33;
    const unsigned* ts = (const unsigned*)(ws + SM_TOKSLOT); const float* gt = (const float*)(ws + SM_GATE); const unsigned char* Y2 = ws + WS_Y2;
    const int tw = 64 * b + 8 * F.wave;
    const u32x4 sl = *(const u32x4*)(ts + (tw + (F.lane & 7)) * 4); const f32x4 gl = *(const f32x4*)(gt + (tw + (F.lane & 7)) * 4) * (1.0f / YSCALE);
    const int r0 = row_start[sl.x >> 16] + (int)(sl.x & 0xffffu), r1 = row_start[sl.y >> 16] + (int)(sl.y & 0xffffu), r2 = row_start[sl.z >> 16] + (int)(sl.z & 0xffffu), r3 = row_start[sl.w >> 16] + (int)(sl.w & 0xffffu);
#pragma unroll
    for (int bt = 0; bt < 2; ++bt) {
        unsigned yv[4][4][4]; u32x2 hv[4][4];
#pragma unroll
        for (int i = 0; i < 4; ++i) { const int k = 4 * bt + i;
            const unsigned char* y0 = Y2 + (size_t)__builtin_amdgcn_readlane(r0, k) * D + 4 * F.lane; const unsigned char* y1 = Y2 + (size_t)__builtin_amdgcn_readlane(r1, k) * D + 4 * F.lane;
            const unsigned char* y2 = Y2 + (size_t)__builtin_amdgcn_readlane(r2, k) * D + 4 * F.lane; const unsigned char* y3 = Y2 + (size_t)__builtin_amdgcn_readlane(r3, k) * D + 4 * F.lane;
            const bf16* hq = (const bf16*)(ws + WS_HBF) + (size_t)(tw + k) * D + 4 * F.lane;
#pragma unroll
            for (int j = 0; j < 4; ++j) { yv[i][0][j] = __builtin_nontemporal_load((const unsigned*)(y0 + 256 * j)); yv[i][1][j] = __builtin_nontemporal_load((const unsigned*)(y1 + 256 * j));
                yv[i][2][j] = __builtin_nontemporal_load((const unsigned*)(y2 + 256 * j)); yv[i][3][j] = __builtin_nontemporal_load((const unsigned*)(y3 + 256 * j));
                hv[i][j] = __builtin_nontemporal_load((const u32x2*)(hq + 256 * j)); } }
#pragma unroll
        for (int i = 0; i < 4; ++i) { const int k = 4 * bt + i;
            const float g0 = __uint_as_float(__builtin_amdgcn_readlane(__float_as_uint(gl.x), k)), g1 = __uint_as_float(__builtin_amdgcn_readlane(__float_as_uint(gl.y), k));
            const float g2 = __uint_as_float(__builtin_amdgcn_readlane(__float_as_uint(gl.z), k)), g3 = __uint_as_float(__builtin_amdgcn_readlane(__float_as_uint(gl.w), k));
            float* op = F.out + (size_t)(tw + k) * D + 4 * F.lane;
#pragma unroll
            for (int j = 0; j < 4; ++j) { f32x4 o = (f32x4){bflo(hv[i][j].x), bfhi(hv[i][j].x), bflo(hv[i][j].y), bfhi(hv[i][j].y)};
                o += fp8x4_to_f32(yv[i][0][j]) * g0 + fp8x4_to_f32(yv[i][1][j]) * g1 + fp8x4_to_f32(yv[i][2][j]) * g2 + fp8x4_to_f32(yv[i][3][j]) * g3;
                *(f32x4*)(op + 256 * j) = o; } }
    }
}

constexpr int N_LAUNCHES = MK_N_LAUNCHES, PER_PHASE = 10, P1X_K = 8, LRU_NP = 16;
__global__ void __launch_bounds__(NTHR, 2) hymba_fwd(Args args) {
    extern __shared__ __attribute__((aligned(16))) unsigned char lds[];
    Frame F;
    F.lds = (LAS unsigned char*)lds;
    F.tid = threadIdx.x; F.lane = F.tid & 63; F.wave = __builtin_amdgcn_readfirstlane(F.tid >> 6);
    F.G = gridDim.x; F.bid = blockIdx.x; F.out = args.out; F.ws = args.ws;
    unsigned char* ws = args.ws;
    gu32* ctl = (gu32*)(ws + WS_CTL);
    for (int u = F.tid; u < (LDS_BYTES - LDSCTL_OFF) / 4; u += NTHR) ((LAS unsigned*)(F.lds + LDSCTL_OFF))[u] = 0u;
    __syncthreads();
    if (F.tid == 0) { LAS unsigned long long* pt = (LAS unsigned long long*)(F.lds + PTAB_OFF);
#pragma unroll
        for (int i = 0; i < 29; ++i) pt[i] = (unsigned long long)args.in[i]; }
    __syncthreads();
    const InTab in{(const LAS unsigned*)(F.lds + PTAB_OFF)};
    XcdBarrier bar; bar.bar = (unsigned*)(ctl + CW_BAR); bar.x = 0; bar.st = nullptr;
    if (N_LAUNCHES != PER_PHASE) bar = xcd_barrier_post((unsigned*)(ctl + CW_BAR), (volatile LAS unsigned*)(F.lds + MISC_OFF) + 8);
#define GRID_BAR(seam) do { if (N_LAUNCHES == PER_PHASE) { if (F.tid == 0) __hip_atomic_store(ctl + CW_TMO, 0xBADBA0u | (unsigned)(seam), RLX_AGENT); } else { xcd_barrier(bar); } } while (0)
    const int lo = args.ph_lo, hi = args.ph_hi;
#ifndef PH_MASK
#define PH_MASK 0x3ff
#endif
#define IN(k) (((PH_MASK >> (k)) & 1) && lo <= (k) && (k) < hi)
#define BOTH(k) (IN(k) && IN((k) + 1))
    LAS int* tab = (LAS int*)(F.lds + TAB_OFF);
#define REFRAME() do { int _t = threadIdx.x; asm volatile("" : "+v"(_t)); F.tid = _t; F.lane = _t & 63; F.wave = __builtin_amdgcn_readfirstlane(_t >> 6); } while (0)

    const int p1_units = (S / 256) * (D_INP / 256), p1_first_spare = p1_units - ((p1_units - 1) / F.G) * F.G, p1_spare = p1_first_spare < F.G ? F.G - p1_first_spare : 0;
    const int p1x = (p1_spare * NWAVES * P1X_K <= pg8::W1_PASSES / 2) ? p1_spare * NWAVES * P1X_K : 0, px0 = pg8::W1_PASSES - p1x;
    const int plx = (F.G <= NTILE && 2 * F.G * LRU_NP <= pg8::W1_PASSES / 2) ? 2 * F.G * LRU_NP : 0, pl0 = px0 - plx;
    if (IN(0)) { REFRAME(); p0_prologue(F); if (BOTH(0)) GRID_BAR(0); }
    if (IN(1)) { REFRAME();
        pg8::SchedDense Sd; Sd.init(S, D_INP, F.G, F.bid, (const bf16*)(ws + WS_WIN));
        pg8::EpiInProj E{(bf16*)(ws + WS_U), (const float*)(ws + SM_RSTD1)};
        pg8::gemm_phase(F.lds, (const bf16*)(ws + WS_XB), (unsigned)S * D * 2u, Sd, E);
        if (p1x > 0 && F.bid >= p1_first_spare) { REFRAME(); pg8::W1Rider R; R.init_x(in[I_W1], ws + WS_W1, F.lds, F.wave, px0 + (F.bid - p1_first_spare) * NWAVES + F.wave, p1_spare * NWAVES, pg8::W1_PASSES); R.drain3(F.lane); }
        if (BOTH(1)) GRID_BAR(1);
    }
    if (IN(2)) { REFRAME();
        for (int b = F.bid; b < NTILE; b += F.G) { REFRAME(); const bool first = plx > 0 && b == F.bid; lru_tile_mfma(F, b, first ? pl0 + F.bid * 2 + (F.wave - 6) : 0, 2 * F.G, first ? px0 : 0); }
        REFRAME();
        pg8::W1Rider R; R.init(in[I_W1], ws + WS_W1, F.lds, F.bid * NWAVES + F.wave, F.G * NWAVES, F.wave, 0, 5, pl0);
        for (int b = F.bid; b < NTILE; b += F.G) { REFRAME(); swa_tile_mfma(F, b, R); }
        for (int b = F.bid; b < NTILE; b += F.G) { REFRAME(); mem_tile_mfma(F, b, R); }
        REFRAME(); R.drain(F.lane);
        if (BOTH(2)) GRID_BAR(2);
    }
    if (IN(3)) { REFRAME(); carry_scan(F); if (BOTH(3)) GRID_BAR(3); }
    if (IN(4)) { REFRAME();
        pg8::W1Rider R; R.init(in[I_W1], ws + WS_W1, F.lds, F.bid * NWAVES + F.wave, F.G * NWAVES, F.wave, 5, 7, pl0);
        for (int b = F.bid; b < NTILE; b += F.G) { REFRAME(); lru_fix_tile(F, b, R); }
        REFRAME(); R.drain(F.lane);
        if (BOTH(4)) GRID_BAR(4);
    }
    if (IN(5)) { REFRAME();
        pg8::SchedDense Sd; Sd.init(S, D, F.G, F.bid, (const bf16*)(ws + WS_WOUT));
        pg8::EpiOutProj E{(const bf16*)(ws + WS_XB), (bf16*)(ws + WS_HBF), ws + WS_HB, (float*)(ws + SM_SSQP), in[I_GFFN]};
        pg8::gemm_phase(F.lds, (const bf16*)(ws + WS_Y), (unsigned)S * D * 2u, Sd, E);
        if (BOTH(5)) GRID_BAR(5);
    }
    if (IN(6)) { REFRAME();
        pg8::W1Rider R; R.init(in[I_W1], ws + WS_W1, F.lds, F.bid * NWAVES + F.wave, F.G * NWAVES, F.wave, 7, 1 << 20, pl0);
        for (int b = F.bid; b < NTILE; b += F.G) { REFRAME(); router_tile_mfma(F, b, R); }
        REFRAME(); R.drain3(F.lane);
        if (BOTH(6)) GRID_BAR(6);
    }
    if (IN(7)) { REFRAME();
        moe_tables(F);
        pg8::SchedMoE<true> Sm; Sm.NT = 8; Sm.G = F.G; Sm.c = F.bid; Sm.ntot = tab[32 + 32] * 8; Sm.Bt = (const bf16*)(ws + WS_W1); Sm.estride = (unsigned)FF2 * P8; Sm.Bbytes = 32u * FF2 * P8;
        Sm.cnt = tab; Sm.tile_start = tab + 32; Sm.row_start = tab + 65; Sm.mt_expert = tab + 97; Sm.list = (const unsigned*)(ws + SM_LIST);
        pg8::EpiMoE1 E{in[I_W2], ws + WS_W2, ws + WS_ACT, (const float*)(ws + SM_B1P), (const float*)(ws + SM_RSLIST), tab};
        pg8::gemm_phase(F.lds, (const bf16*)(ws + WS_HB), (unsigned)S * P8, Sm, E);
        if (BOTH(7)) GRID_BAR(7);
    }
    if (IN(8)) { REFRAME();
        if (!IN(7)) moe_tables(F);
        pg8::SchedMoE<false> Sm; Sm.NT = 4; Sm.G = F.G; Sm.c = F.bid; Sm.ntot = tab[32 + 32] * 4; Sm.Bt = (const bf16*)(ws + WS_W2); Sm.estride = (unsigned)D * P8; Sm.Bbytes = 32u * D * P8;
        Sm.cnt = tab; Sm.tile_start = tab + 32; Sm.row_start = tab + 65; Sm.mt_expert = tab + 97; Sm.list = nullptr;
        pg8::EpiMoE2 E{ws + WS_Y2, in[I_B2]};
        pg8::gemm_phase(F.lds, (const bf16*)(ws + WS_ACT), (unsigned)MAXMT * 256u * P8, Sm, E);
        if (BOTH(8)) GRID_BAR(8);
    }
    if (IN(9)) { REFRAME();
        if (!IN(7)) moe_tables(F);
        for (int b = F.bid; b < NTILE; b += F.G) combine_tile2(F, b);
    }
#undef IN
#undef BOTH
}

extern "C" void kernel_launch(void* const* d_in, const int* in_sizes, int n_in, void* d_out, int out_size, void* d_ws, size_t ws_size, hipStream_t stream) {
    static int grid = 0;
    if (grid == 0) {
        if (n_in != 29 || out_size != S * D || ws_size < WS_END) { fprintf(stderr, "kernel_launch: unexpected problem (n_in %d, out %d, ws %zu)\n", n_in, out_size, ws_size); grid = -1; return; }
        int dev = 0, cus = 0, per_cu = 0;
        if (hipGetDevice(&dev) != hipSuccess || hipDeviceGetAttribute(&cus, hipDeviceAttributeMultiprocessorCount, dev) != hipSuccess) { grid = -1; return; }
        if (hipFuncSetAttribute((const void*)hymba_fwd, hipFuncAttributeMaxDynamicSharedMemorySize, LDS_BYTES) != hipSuccess) { fprintf(stderr, "kernel_launch: hipFuncSetAttribute failed\n"); grid = -1; return; }
        if (hipOccupancyMaxActiveBlocksPerMultiprocessor(&per_cu, (const void*)hymba_fwd, NTHR, LDS_BYTES) != hipSuccess || per_cu < 1) fprintf(stderr, "kernel_launch: occupancy query reports %d\n", per_cu);
        (void)hipGetLastError();
        grid = cus;
    }
    if (grid < 0) return;
    if (hipMemsetAsync((char*)d_ws + WS_CTL, 0, CTL_ZERO_BYTES, stream) != hipSuccess) return;
    Args a{};
    for (int i = 0; i < 29; ++i) a.in[i] = (const float*)d_in[i];
    a.out = (float*)d_out; a.ws = (unsigned char*)d_ws;
    if (N_LAUNCHES == 1) { a.ph_lo = 0; a.ph_hi = PER_PHASE; hipLaunchKernelGGL(hymba_fwd, dim3(grid), dim3(NTHR), LDS_BYTES, stream, a); }
    else for (int li = 0; li < PER_PHASE; ++li) { a.ph_lo = li; a.ph_hi = li + 1; hipLaunchKernelGGL(hymba_fwd, dim3(grid), dim3(NTHR), LDS_BYTES, stream, a); }
}
```
